# Optimizing an MI355X kernel written in HIP

```python
import jax, jax.numpy as jnp
from jax import lax
import numpy as np

D_MODEL = 1024
BATCH = 16
SEQ = 2048
DEPTH = 4

GRID_W = 64
CTX_LEN = 256
NA_HEADS = 6
NA_HEAD_DIM = 64
NA_WIDTH = NA_HEADS * NA_HEAD_DIM
NA_WIN_H = 8
NA_WIN_W = 16
MLA_HEADS = 6
MLA_Q_RANK = 256
MLA_KV_RANK = 128
MLA_NOPE = 64
MLA_ROPE = 32
MLA_V = 64
LRU_WIDTH = 256
LRU_HEADS = 4
LRU_BLOCK = LRU_WIDTH // LRU_HEADS
LRU_CONV_W = 4
LRU_C = 8.0
MIX_WIDTH = NA_WIDTH + MLA_HEADS * MLA_V + LRU_WIDTH
FFN_HIDDEN = -(-(8 * D_MODEL) // (3 * 256)) * 256
IN_SPLITS = (NA_WIDTH, NA_WIDTH, NA_WIDTH, MLA_Q_RANK, MLA_KV_RANK, MLA_ROPE, LRU_WIDTH, LRU_WIDTH)
Q_BLOCK = 128
ROPE_BASE = 10000.0
EPS = 1e-6
NA_SCALE = NA_HEAD_DIM ** -0.5
MLA_SCALE = (MLA_NOPE + MLA_ROPE) ** -0.5

kernel_name = 'hybrid_na_mla_rglru_dit_block'


def _rmsnorm(x, g):
    xf = x.astype(jnp.float32)
    y = xf * lax.rsqrt(jnp.mean(xf * xf, axis=-1, keepdims=True) + EPS)
    return (y * g.astype(jnp.float32)).astype(x.dtype)


def _heads(t, n):
    return t.reshape(t.shape[:-1] + (n, t.shape[-1] // n))


def _adaln(cvec, w, b):
    m = jax.nn.silu(cvec) @ w + b
    return jnp.split(m[:, None, :], 6, axis=-1)


def _modulate(x, shift, scale):
    return x * (1.0 + scale) + shift


def _split_cols(u):
    return jnp.split(u, np.cumsum(IN_SPLITS)[:-1].tolist(), axis=-1)


def _axial_angles(n_tok, rot_dim):
    t = jnp.arange(n_tok)
    row = (t // GRID_W).astype(jnp.float32)
    col = (t % GRID_W).astype(jnp.float32)
    n_freq = rot_dim // 4
    inv = ROPE_BASE ** (-jnp.arange(n_freq, dtype=jnp.float32) / n_freq)
    return row[:, None] * inv, col[:, None] * inv


def _rope_half(z, ang):
    z1, z2 = jnp.split(z, 2, axis=-1)
    cos = jnp.cos(ang)[:, None, :]
    sin = jnp.sin(ang)[:, None, :]
    return jnp.concatenate([z1 * cos - z2 * sin, z1 * sin + z2 * cos], axis=-1)


def _axial_rope(z, angs):
    zr, zc = jnp.split(z, 2, axis=-1)
    return jnp.concatenate([_rope_half(zr, angs[0]), _rope_half(zc, angs[1])], axis=-1).astype(z.dtype)


def _attend(q, k, v, scale):
    s = jnp.einsum('bqhd,bkhd->bhqk', q, k, preferred_element_type=jnp.float32) * scale
    p = jax.nn.softmax(s, axis=-1).astype(v.dtype)
    return jnp.einsum('bhqk,bkhd->bqhd', p, v)


def _neighborhood_attention(q, k, v, k_ctx, v_ctx, rpb, rows):
    B, S, H, dh = q.shape
    kh = min(NA_WIN_H, rows)
    ncb = GRID_W // NA_WIN_W
    span = 2 * NA_WIN_W
    qcol = np.arange(GRID_W).reshape(ncb, NA_WIN_W)
    kcol = np.clip(qcol[:, :1] - NA_WIN_W // 2, 0, GRID_W - span) + np.arange(span)
    qcs = np.clip(qcol - NA_WIN_W // 2, 0, GRID_W - NA_WIN_W)[..., None]
    col_ok = (kcol[:, None, :] >= qcs) & (kcol[:, None, :] < qcs + NA_WIN_W)
    col_rel = np.clip(kcol[:, None, :] - qcol[..., None], 1 - NA_WIN_W, NA_WIN_W - 1) + NA_WIN_W - 1
    mask = np.broadcast_to(col_ok[:, :, None, :], (ncb, NA_WIN_W, kh, span)).reshape(ncb, NA_WIN_W, kh * span)
    qg = q.reshape(B, rows, GRID_W, H, dh)
    kg = k.reshape(B, rows, GRID_W, H, dh)
    vg = v.reshape(B, rows, GRID_W, H, dh)
    n_lat = kh * span

    def row_block(r):
        rs = jnp.clip(r - kh // 2, 0, rows - kh)
        k_rows = lax.dynamic_slice_in_dim(kg, rs, kh, axis=1)
        v_rows = lax.dynamic_slice_in_dim(vg, rs, kh, axis=1)
        k_blk = k_rows[:, :, kcol].transpose(0, 2, 1, 3, 4, 5).reshape(B, ncb, n_lat, H, dh)
        v_blk = v_rows[:, :, kcol].transpose(0, 2, 1, 3, 4, 5).reshape(B, ncb, n_lat, H, dh)
        q_blk = lax.dynamic_index_in_dim(qg, r, axis=1, keepdims=False).reshape(B, ncb, NA_WIN_W, H, dh)
        row_rel = rs + jnp.arange(kh) - r + NA_WIN_H - 1
        bias = rpb[:, row_rel][:, :, col_rel]
        bias = bias.transpose(0, 2, 3, 1, 4).reshape(H, ncb, NA_WIN_W, n_lat).astype(jnp.float32)
        s_lat = jnp.einsum('bnqhd,bnkhd->bhnqk', q_blk, k_blk, preferred_element_type=jnp.float32) * NA_SCALE + bias
        s_lat = jnp.where(mask, s_lat, -jnp.inf)
        s_ctx = jnp.einsum('bnqhd,bchd->bhnqc', q_blk, k_ctx, preferred_element_type=jnp.float32) * NA_SCALE
        p = jax.nn.softmax(jnp.concatenate([s_lat, s_ctx], axis=-1), axis=-1).astype(v.dtype)
        o = (jnp.einsum('bhnqk,bnkhd->bnqhd', p[..., :n_lat], v_blk)
             + jnp.einsum('bhnqc,bchd->bnqhd', p[..., n_lat:], v_ctx))
        return o.reshape(B, GRID_W, H, dh)

    out = lax.map(row_block, jnp.arange(rows))
    return out.transpose(1, 0, 2, 3, 4).reshape(B, S, H, dh)


def _mla_q(cq, cq_g, w_qb, q_g, angs):
    q = _heads(_rmsnorm(cq, cq_g) @ w_qb, MLA_HEADS)
    q_nope = _rmsnorm(q[..., :MLA_NOPE], q_g[:MLA_NOPE])
    q_rope = _rmsnorm(q[..., MLA_NOPE:], q_g[MLA_NOPE:])
    if angs is not None:
        q_rope = _axial_rope(q_rope, angs)
    return jnp.concatenate([q_nope, q_rope], axis=-1)


def _mla_kv(ckv, kr, ckv_g, w_kvb, k_g, angs):
    kv = _heads(_rmsnorm(ckv, ckv_g) @ w_kvb, MLA_HEADS)
    k_nope = _rmsnorm(kv[..., :MLA_NOPE], k_g[:MLA_NOPE])
    v = kv[..., MLA_NOPE:]
    k_rope = _rmsnorm(kr, k_g[MLA_NOPE:])[..., None, :]
    if angs is not None:
        k_rope = _axial_rope(k_rope, angs)
    k_rope = jnp.broadcast_to(k_rope, k_nope.shape[:-1] + (MLA_ROPE,))
    return jnp.concatenate([k_nope, k_rope], axis=-1), v


def _mla_latent_attention(q, k, v, k_ctx, v_ctx):
    B, S, H, dq = q.shape
    kk = jnp.concatenate([k_ctx, k], axis=1)
    vv = jnp.concatenate([v_ctx, v], axis=1)
    qb = q.reshape(B, S // Q_BLOCK, Q_BLOCK, H, dq).swapaxes(0, 1)
    out = lax.map(lambda qi: _attend(qi, kk, vv, MLA_SCALE), qb)
    return out.swapaxes(0, 1).reshape(B, S, H, v.shape[-1])


def _dwconv(x, w, b):
    y = lax.conv_general_dilated(x, w[:, None, :].astype(x.dtype), window_strides=(1,),
                                 padding=[((LRU_CONV_W - 1) // 2, LRU_CONV_W // 2)],
                                 dimension_numbers=('NWC', 'WIO', 'NWC'), feature_group_count=x.shape[-1])
    return y + b


def _rglru_coeffs(xc, w_a, b_a, w_x, b_x, lam):
    B, L, W = xc.shape
    xf = xc.astype(jnp.float32)
    xh = xf.reshape(B, L, LRU_HEADS, LRU_BLOCK)
    gate_a = jnp.einsum('blhi,dhij->dblhj', xh, w_a.astype(jnp.float32)).reshape(2, B, L, W) + b_a.astype(jnp.float32)[:, None, None, :]
    gate_x = jnp.einsum('blhi,dhij->dblhj', xh, w_x.astype(jnp.float32)).reshape(2, B, L, W) + b_x.astype(jnp.float32)[:, None, None, :]
    log_a = -LRU_C * jax.nn.sigmoid(gate_a) * jax.nn.softplus(-lam.astype(jnp.float32))[:, None, None, :]
    a = jnp.exp(log_a)
    u = jnp.sqrt(-jnp.expm1(2.0 * log_a)) * (jax.nn.sigmoid(gate_x) * xf[None])
    return a, u


def _linear_scan(a, u, h0, reverse):
    def step(h, au):
        h = au[0] * h + au[1]
        return h, h
    h_last, hs = lax.scan(step, h0, (a.swapaxes(0, 1), u.swapaxes(0, 1)), reverse=reverse)
    return hs.swapaxes(0, 1), h_last


def _swiglu(h, w_gate, w_up, w_down):
    return (jax.nn.silu(h @ w_gate) * (h @ w_up)) @ w_down


def setup_inputs(seed: int = 0) -> dict:
    key = jax.random.key(seed)
    ks = iter(jax.random.split(key, 32))
    f32 = jnp.float32

    def nrm(shape, scale):
        return jax.random.normal(next(ks), shape, f32) * scale

    def gain(shape):
        return 1.0 + nrm(shape, 0.05)

    lam_u = jax.random.uniform(next(ks), (DEPTH, 2, LRU_WIDTH), f32, 0.9, 0.999)
    a0 = lam_u ** (1.0 / LRU_C)
    return {
        'x': nrm((BATCH, SEQ, D_MODEL), 1.0),
        'c': nrm((BATCH, D_MODEL), 1.0),
        'ctx': nrm((BATCH, CTX_LEN, D_MODEL), 1.0),
        'c_ctx': nrm((D_MODEL,), 1.0),
        'ada_w': nrm((DEPTH, D_MODEL, 6 * D_MODEL), 0.5 * D_MODEL ** -0.5),
        'ada_b': nrm((DEPTH, 6 * D_MODEL), 0.02),
        'norm_mix_g': gain((DEPTH, D_MODEL)),
        'norm_ffn_g': gain((DEPTH, D_MODEL)),
        'w_in': nrm((DEPTH, D_MODEL, sum(IN_SPLITS)), D_MODEL ** -0.5),
        'na_q_g': gain((DEPTH, NA_HEAD_DIM)),
        'na_k_g': gain((DEPTH, NA_HEAD_DIM)),
        'na_rpb': nrm((DEPTH, NA_HEADS, 2 * NA_WIN_H - 1, 2 * NA_WIN_W - 1), 0.2),
        'mla_cq_g': gain((DEPTH, MLA_Q_RANK)),
        'mla_w_qb': nrm((DEPTH, MLA_Q_RANK, MLA_HEADS * (MLA_NOPE + MLA_ROPE)), MLA_Q_RANK ** -0.5),
        'mla_ckv_g': gain((DEPTH, MLA_KV_RANK)),
        'mla_w_kvb': nrm((DEPTH, MLA_KV_RANK, MLA_HEADS * (MLA_NOPE + MLA_V)), MLA_KV_RANK ** -0.5),
        'mla_q_g': gain((DEPTH, MLA_NOPE + MLA_ROPE)),
        'mla_k_g': gain((DEPTH, MLA_NOPE + MLA_ROPE)),
        'lru_conv_w': nrm((DEPTH, LRU_CONV_W, LRU_WIDTH), LRU_CONV_W ** -0.5),
        'lru_conv_b': nrm((DEPTH, LRU_WIDTH), 0.02),
        'lru_w_a': nrm((DEPTH, 2, LRU_HEADS, LRU_BLOCK, LRU_BLOCK), LRU_BLOCK ** -0.5),
        'lru_b_a': nrm((DEPTH, 2, LRU_WIDTH), 0.02),
        'lru_w_x': nrm((DEPTH, 2, LRU_HEADS, LRU_BLOCK, LRU_BLOCK), LRU_BLOCK ** -0.5),
        'lru_b_x': nrm((DEPTH, 2, LRU_WIDTH), 0.02),
        'lru_lambda': jnp.log(a0) - jnp.log1p(-a0),
        'w_out': nrm((DEPTH, MIX_WIDTH, D_MODEL), MIX_WIDTH ** -0.5),
        'ffn_w_gate': nrm((DEPTH, D_MODEL, FFN_HIDDEN), D_MODEL ** -0.5),
        'ffn_w_up': nrm((DEPTH, D_MODEL, FFN_HIDDEN), D_MODEL ** -0.5),
        'ffn_w_down': nrm((DEPTH, FFN_HIDDEN, D_MODEL), FFN_HIDDEN ** -0.5),
    }


def reference(x, c, ctx, c_ctx, ada_w, ada_b, norm_mix_g, norm_ffn_g, w_in, na_q_g, na_k_g, na_rpb,
              mla_cq_g, mla_w_qb, mla_ckv_g, mla_w_kvb, mla_q_g, mla_k_g,
              lru_conv_w, lru_conv_b, lru_w_a, lru_b_a, lru_w_x, lru_b_x, lru_lambda,
              w_out, ffn_w_gate, ffn_w_up, ffn_w_down):
    B, S, _ = x.shape
    C = ctx.shape[1]
    rows = S // GRID_W
    angs = _axial_angles(S, MLA_ROPE)
    h, hc = x, ctx
    for l in range(DEPTH):
        last = l == DEPTH - 1
        sh_m, sc_m, g_m, sh_f, sc_f, g_f = _adaln(c, ada_w[l], ada_b[l])
        csh_m, csc_m, cg_m, csh_f, csc_f, cg_f = _adaln(c_ctx[None], ada_w[l], ada_b[l])

        u = _modulate(_rmsnorm(h, norm_mix_g[l]), sh_m, sc_m) @ w_in[l]
        uc = _modulate(_rmsnorm(hc, norm_mix_g[l]), csh_m, csc_m) @ w_in[l]
        na_q, na_k, na_v, cq, ckv, kr, lx, lg = _split_cols(u)
        cna_q, cna_k, cna_v, ccq, cckv, ckr, clx, clg = _split_cols(uc)

        q = _rmsnorm(_heads(na_q, NA_HEADS), na_q_g[l])
        k = _rmsnorm(_heads(na_k, NA_HEADS), na_k_g[l])
        v = _heads(na_v, NA_HEADS)
        kc = _rmsnorm(_heads(cna_k, NA_HEADS), na_k_g[l])
        vc = _heads(cna_v, NA_HEADS)
        na_o = _neighborhood_attention(q, k, v, kc, vc, na_rpb[l], rows)

        mq = _mla_q(cq, mla_cq_g[l], mla_w_qb[l], mla_q_g[l], angs)
        mk, mv = _mla_kv(ckv, kr, mla_ckv_g[l], mla_w_kvb[l], mla_k_g[l], angs)
        mkc, mvc = _mla_kv(cckv, ckr, mla_ckv_g[l], mla_w_kvb[l], mla_k_g[l], None)
        mla_o = _mla_latent_attention(mq, mk, mv, mkc, mvc)

        xcc = _dwconv(clx, lru_conv_w[l], lru_conv_b[l])
        a_c, u_c = _rglru_coeffs(xcc, lru_w_a[l], lru_b_a[l], lru_w_x[l], lru_b_x[l], lru_lambda[l])
        zeros = jnp.zeros((B, LRU_WIDTH), jnp.float32)
        hcf, hcf_last = _linear_scan(a_c[0], u_c[0], zeros, False)
        hcb, hcb_last = _linear_scan(a_c[1], u_c[1], zeros, True)
        xcl = _dwconv(lx, lru_conv_w[l], lru_conv_b[l])
        a_l, u_l = _rglru_coeffs(xcl, lru_w_a[l], lru_b_a[l], lru_w_x[l], lru_b_x[l], lru_lambda[l])
        hf, _ = _linear_scan(a_l[0], u_l[0], hcf_last, False)
        hb, _ = _linear_scan(a_l[1], u_l[1], hcb_last, True)
        lru_o = jax.nn.gelu(lg) * (hf + hb).astype(lg.dtype)

        o_lat = jnp.concatenate([na_o.reshape(B, S, NA_WIDTH), mla_o.reshape(B, S, MLA_HEADS * MLA_V), lru_o], axis=-1)
        h = h + g_m * (o_lat @ w_out[l])
        h = h + g_f * _swiglu(_modulate(_rmsnorm(h, norm_ffn_g[l]), sh_f, sc_f), ffn_w_gate[l], ffn_w_up[l], ffn_w_down[l])

        if not last:
            qc = _rmsnorm(_heads(cna_q, NA_HEADS), na_q_g[l])
            na_c = _attend(qc, kc, vc, NA_SCALE).reshape(B, C, NA_WIDTH)
            mqc = _mla_q(ccq, mla_cq_g[l], mla_w_qb[l], mla_q_g[l], None)
            mla_c = _attend(mqc, mkc, mvc, MLA_SCALE).reshape(B, C, MLA_HEADS * MLA_V)
            lru_c = jax.nn.gelu(clg) * (hcf + hcb).astype(clg.dtype)
            o_ctx = jnp.concatenate([na_c, mla_c, lru_c], axis=-1)
            hc = hc + cg_m * (o_ctx @ w_out[l])
            hc = hc + cg_f * _swiglu(_modulate(_rmsnorm(hc, norm_ffn_g[l]), csh_f, csc_f), ffn_w_gate[l], ffn_w_up[l], ffn_w_down[l])
    return h
```

```cpp
#include <hip/hip_runtime.h>
#include <hip/hip_cooperative_groups.h>
#include <cstdio>
namespace cg = cooperative_groups;

constexpr int DM = 1024, NB = 16, SEQ = 2048, DEPTH = 4, CTXL = 256;
constexpr int NLAT = NB * SEQ, NCTX = NB * CTXL, MTOK = NLAT + NCTX;
constexpr int NIN = 2080, NINP = 2304;
constexpr int OQ = 0, OKK = 384, OV = 768, OCQ = 1152, OCKV = 1408, OKR = 1536, OLX = 1568, OLG = 1824;
constexpr int FF = 2816, OW = 1280;
constexpr float EPS = 1e-6f;
constexpr float NA_SCALE = 0.125f;
constexpr float LOG2E = 1.4426950408889634f;
constexpr float MLA_SCALE = 0.10206207261596575f * LOG2E;
constexpr float NA_QSCALE = 0.125f * LOG2E;

constexpr size_t WS_MOD = 0;
constexpr size_t WS_HC = WS_MOD + (size_t)4 * 17 * 6144 * 4;
constexpr size_t WS_WIN = WS_HC + (size_t)NCTX * DM * 4;
constexpr size_t WS_WOUT = WS_WIN + (size_t)4 * NINP * DM * 2;
constexpr size_t WS_WGU = WS_WOUT + (size_t)4 * DM * OW * 2;
constexpr size_t WS_WD = WS_WGU + (size_t)4 * 2 * FF * DM * 2;
constexpr size_t WS_AO = WS_WD + (size_t)4 * DM * FF * 2;
constexpr size_t WS_U = WS_AO + (size_t)MTOK * OW * 2;
constexpr size_t WS_MQ = WS_U + (size_t)MTOK * NINP * 2;
constexpr size_t WS_MK = WS_MQ + (size_t)MTOK * 576 * 2;
constexpr size_t WS_MV = WS_MK + (size_t)MTOK * 576 * 2;
constexpr size_t WS_A2 = WS_MV + (size_t)MTOK * 384 * 2;
constexpr size_t WS_WUP = WS_A2 + (size_t)MTOK * 384 * 2;
constexpr size_t WS_ROPE = WS_WUP + (size_t)4 * 1536 * 384 * 2;
constexpr size_t WS_BAR = WS_ROPE + 64 * 8 * 2 * 4 + 64 * 4;
constexpr size_t WS_Q = WS_BAR + 3456 * 4;
constexpr size_t WS_END = WS_Q + 4 * 8 * 64 * 4;
constexpr size_t WS_HID = WS_U;
static_assert((size_t)MTOK * FF * 2 <= WS_MK - WS_U, "Hid alias");
static_assert(WS_END <= (size_t)512 * 1024 * 1024, "workspace");

constexpr int LDS_BYTES = 131072 + 16;

typedef unsigned short bf16_t;
__device__ __forceinline__ float bf2f(bf16_t v) { return __uint_as_float(((unsigned)v) << 16); }
__device__ __forceinline__ float bflo(unsigned w) { return __uint_as_float(w << 16); }
__device__ __forceinline__ float bfhi(unsigned w) { return __uint_as_float(w & 0xffff0000u); }
typedef float g_f32x2 __attribute__((ext_vector_type(2)));
typedef __bf16 g_bf16x2 __attribute__((ext_vector_type(2)));
__device__ __forceinline__ unsigned pk2(float lo, float hi) { const g_f32x2 f = {lo, hi}; return __builtin_bit_cast(unsigned, __builtin_convertvector(f, g_bf16x2)); }
__device__ __forceinline__ bf16_t f2bf(float f) { return (bf16_t)(pk2(f, 0.0f) & 0xffffu); }
template <int K> __device__ __forceinline__ float swz(float v) { return __int_as_float(__builtin_amdgcn_ds_swizzle(__float_as_int(v), (K << 10) | 0x1f)); }
__device__ __forceinline__ float x32_sum(float v) { auto r = __builtin_amdgcn_permlane32_swap(__float_as_uint(v), __float_as_uint(v), false, false); return __uint_as_float(r[0]) + __uint_as_float(r[1]); }
__device__ __forceinline__ float x32_max(float v) { auto r = __builtin_amdgcn_permlane32_swap(__float_as_uint(v), __float_as_uint(v), false, false); return fmaxf(__uint_as_float(r[0]), __uint_as_float(r[1])); }
__device__ __forceinline__ float wave_sum(float v) {
    v += swz<1>(v); v += swz<2>(v); v += swz<4>(v); v += swz<8>(v); v += swz<16>(v);
    return x32_sum(v);
}

struct Params { const float* in[29]; float* out; unsigned char* ws; };

__device__ __forceinline__ unsigned long long karg_q(int i) {
    typedef const __attribute__((address_space(4))) unsigned long long* kp_t;
    kp_t ka = (kp_t)__builtin_amdgcn_kernarg_segment_ptr();
    return *(volatile kp_t)(ka + i);
}
#define GASP __attribute__((address_space(1)))
#define PIN(i) ((const float*)(const GASP float*)karg_q(i))
#define POUT ((float*)(GASP float*)karg_q(29))
#define PWS ((unsigned char*)(GASP unsigned char*)karg_q(30))
__device__ __forceinline__ int obid() { int b = blockIdx.x; asm volatile("" : "+s"(b)); return b; }
__device__ __forceinline__ int otid() { int t = threadIdx.x; asm volatile("" : "+v"(t)); return t; }

namespace pg8 {
#define PG8_LAS __attribute__((address_space(3)))
typedef unsigned short bf16_t;
typedef short bf16x8 __attribute__((ext_vector_type(8)));
typedef float f32x4 __attribute__((ext_vector_type(4)));
typedef unsigned u32x4 __attribute__((ext_vector_type(4)));
typedef unsigned u32x2 __attribute__((ext_vector_type(2)));
constexpr int BM = 256, BK = 64, HALF = 128, HTB = HALF * BK * 2  , STAGE_BYTES = 8 * HTB, NXCD = 8, WGM = 8;

__host__ __device__ __forceinline__ int lds_byte(int r, int c) { const int st = (r >> 4) * 2 + (c >> 5), rr = r & 15, cc = c & 31, ob = rr * 64 + cc * 2; return st * 1024 + (ob ^ (((ob >> 9) & 1) << 5)); }
__host__ __device__ __forceinline__ void stage_rc(int b, int& R, int& C) { const int st = b / 1024, sb = b % 1024, swz = sb ^ (((sb >> 9) & 1) << 5); R = (st >> 1) * 16 + swz / 64; C = (st & 1) * 32 + (swz % 64) / 2; }
__host__ __device__ __forceinline__ int perm32(int rho) { const int n = rho >> 4, i = rho & 15; return 8 * (i >> 2) + 4 * n + (i & 3); }

struct Unit { int pm, pn, kh, k0, kn; };
struct Gemm { const bf16_t* A; const bf16_t* Bt; int M, N, K; };

struct StaticOrder {
    static constexpr bool SPLIT = false;
    int nM, nN, nwg, G, c;
    __host__ __device__ void init(int M, int N, int G_, int c_) { nM = M / BM; nN = N / BM; nwg = nM * nN; G = G_; c = c_; }
    __host__ __device__ bool next(int i, Unit& u) const {
        const long L = (long)i * G + c; if (L >= nwg) return false;
        int wgid = (int)L; { const int q = nwg / NXCD, r = nwg % NXCD, xcd = wgid % NXCD, off = wgid / NXCD; wgid = (xcd < r ? xcd * (q + 1) : r * (q + 1) + (xcd - r) * q) + off; }
        const int nig = WGM * nN, gid = wgid / nig, fm = gid * WGM, gsz = (nM - fm) < WGM ? (nM - fm) : WGM;
        u.pm = fm + ((wgid % nig) % gsz); u.pn = (wgid % nig) / gsz; u.kh = -1; return true;
    }
    __device__ __forceinline__ void a_ready(const Unit&) const {}
    __device__ __forceinline__ void done(const Unit&) const {}
};


struct CtxSplitOrder {
    static constexpr bool SPLIT = true;
    StaticOrder lat; int G, c, nctx;
    __device__ void init(bool has_ctx, int G_, int c_) { lat.init(32768, 1024, G_, c_); G = G_; c = c_; nctx = has_ctx ? 128 : 0; }
    __device__ bool next(int i, Unit& u) const {
        long L = (long)i * G + c; if (L < 512) return lat.next(i, u);
        L -= 512; if (L >= nctx) return false;
        const int t = (int)L >> 1; u.pm = 128 + (t >> 2); u.pn = t & 3; u.kh = (int)L & 1; return true;
    }
    __device__ __forceinline__ void krange(const Unit& u, int nt, int& k0, int& kn) const { if (u.kh >= 0) { kn = nt >> 1; k0 = u.kh * kn; } else { k0 = 0; kn = nt; } }
    __device__ __forceinline__ void a_ready(const Unit&) const {}
    __device__ __forceinline__ void done(const Unit&) const {}
};
struct UpOrder : StaticOrder {
    static constexpr bool SPLIT = true;
    __device__ __forceinline__ void krange(const Unit& u, int nt, int& k0, int& kn) const { if (u.pn < 3) { k0 = 0; kn = 4; } else { k0 = 4; kn = 2; } }
};

typedef float f32x2c __attribute__((ext_vector_type(2)));
typedef __bf16 bf16x2c __attribute__((ext_vector_type(2)));
__device__ __forceinline__ unsigned cvt_pk_bf16(float lo, float hi) { const f32x2c f = {lo, hi}; return __builtin_bit_cast(unsigned, __builtin_convertvector(f, bf16x2c)); }
struct EpiBf16 {
    static constexpr bool PERM = true, AFTER_DRAIN = false;
    bf16_t* O; int ldc;
    __device__ __forceinline__ void operator()(const f32x4 (&acc)[2][2][4][2], const Unit& u, int wr, int wc, int fr, int fq) const {
        const int row0 = u.pm * BM + wr * 64 + fr; const int col0 = u.pn * BM + wc * 32 + 8 * fq;
#pragma unroll
        for (int ai = 0; ai < 2; ++ai)
#pragma unroll
            for (int m = 0; m < 4; ++m) { bf16_t* rowp = O + (size_t)(row0 + ai * HALF + m * 16) * ldc + col0;
#pragma unroll
                for (int bj = 0; bj < 2; ++bj) { const f32x4 v0 = acc[ai][bj][m][0], v1 = acc[ai][bj][m][1];
                    u32x4 w; w.x = cvt_pk_bf16(v0[0], v0[1]); w.y = cvt_pk_bf16(v0[2], v0[3]); w.z = cvt_pk_bf16(v1[0], v1[1]); w.w = cvt_pk_bf16(v1[2], v1[3]);
                    *(u32x4*)(rowp + bj * HALF) = w; } }
    }
};
__device__ __forceinline__ float silu_f(float g) { return g * __builtin_amdgcn_rcpf(1.0f + __expf(-g)); }
struct EpiSwiglu {
    static constexpr bool PERM = true, AFTER_DRAIN = false;
    bf16_t* H; int ldh;
    __device__ __forceinline__ void operator()(const f32x4 (&acc)[2][2][4][2], const Unit& u, int wr, int wc, int fr, int fq) const {
        const int row0 = u.pm * BM + wr * 64 + fr; const int col0 = u.pn * HALF + wc * 32 + 8 * fq;
#pragma unroll
        for (int ai = 0; ai < 2; ++ai)
#pragma unroll
            for (int m = 0; m < 4; ++m) { bf16_t* rowp = H + (size_t)(row0 + ai * HALF + m * 16) * ldh + col0;
                const f32x4 g0 = acc[ai][0][m][0], g1 = acc[ai][0][m][1], u0 = acc[ai][1][m][0], u1 = acc[ai][1][m][1];
                u32x4 w; w.x = cvt_pk_bf16(silu_f(g0[0]) * u0[0], silu_f(g0[1]) * u0[1]); w.y = cvt_pk_bf16(silu_f(g0[2]) * u0[2], silu_f(g0[3]) * u0[3]);
                w.z = cvt_pk_bf16(silu_f(g1[0]) * u1[0], silu_f(g1[1]) * u1[1]); w.w = cvt_pk_bf16(silu_f(g1[2]) * u1[2], silu_f(g1[3]) * u1[3]);
                *(u32x4*)rowp = w; }
    }
};
struct EpiRes {
    static constexpr bool PERM = false, AFTER_DRAIN = false;
    const float* in_lat; float* out_lat; const float* in_ctx; float* out_ctx; const float* gate;
    float* part;
    __device__ __forceinline__ void operator()(const f32x4 (&acc)[2][2][4][2], const Unit& u, int wr, int wc, int fr, int fq) const {
        if (u.kh >= 0) {
            float* pb = part + ((size_t)u.kh * 4096 + (size_t)(u.pm - 128) * BM + wr * 64 + fr) * 1024 + u.pn * BM + wc * 32 + 4 * fq;
#pragma unroll
            for (int ai = 0; ai < 2; ++ai)
#pragma unroll
                for (int m = 0; m < 4; ++m)
#pragma unroll
                    for (int bj = 0; bj < 2; ++bj)
#pragma unroll
                        for (int n = 0; n < 2; ++n) *(f32x4*)(pb + (size_t)(ai * HALF + m * 16) * 1024 + bj * HALF + n * 16) = acc[ai][bj][m][n];
            return;
        }
        const bool isctx = u.pm >= 128;
        const float* inb = isctx ? in_ctx : in_lat; float* outb = isctx ? out_ctx : out_lat;
        const int pml = isctx ? u.pm - 128 : u.pm;
        const float* gp = gate + (size_t)(isctx ? 16 : (u.pm >> 3)) * 6144;
        const int row0 = pml * BM + wr * 64 + fr, col0 = u.pn * BM + wc * 32 + 4 * fq;
        f32x4 gv[2][2];
#pragma unroll
        for (int bj = 0; bj < 2; ++bj)
#pragma unroll
            for (int n = 0; n < 2; ++n) gv[bj][n] = *(const f32x4*)(gp + col0 + bj * HALF + n * 16);
#pragma unroll
        for (int ai = 0; ai < 2; ++ai)
#pragma unroll
            for (int m = 0; m < 4; ++m) { const size_t ro = (size_t)(row0 + ai * HALF + m * 16) * 1024 + col0;
#pragma unroll
                for (int bj = 0; bj < 2; ++bj)
#pragma unroll
                    for (int n = 0; n < 2; ++n) { const f32x4 x = *(const f32x4*)(inb + ro + bj * HALF + n * 16);
                        *(f32x4*)(outb + ro + bj * HALF + n * 16) = x + gv[bj][n] * acc[ai][bj][m][n]; } }
    }
};


struct EpiMla {
    static constexpr bool PERM = false, AFTER_DRAIN = false;
    int l;
    __device__ __forceinline__ void operator()(const f32x4 (&acc)[2][2][4][2], const Unit& u, int wr, int wc, int, int) const {
        const int lane_ = ::otid() & 63, fr = lane_ & 15, fq = lane_ >> 4;
        unsigned char* ws = PWS;
        const bool isq = u.pn < 3; const int head = (isq ? u.pn : u.pn - 3) * 2 + (wc >> 1), kind = wc & 1;
        const bool latent = u.pm < 128, is_v = !isq && kind == 1, is_rope = isq && kind == 1, rot = is_rope && latent;
        const int sbj = is_rope ? 8 : 32;
        const float* gsrc = is_v ? (const float*)(ws + WS_ROPE) + 1024 : (isq ? PIN(16) + l * 96 : PIN(17) + l * 96);
        const float* g = gsrc + (is_rope ? 64 + 16 * (fq & 1) : 8 * fq);
        const float* rope = (const float*)(ws + WS_ROPE);
        bf16_t* obase = (bf16_t*)(ws + (is_v ? WS_MV : (isq ? WS_MQ : WS_MK)));
        const int ostride = is_v ? 384 : 576;
        const int ocol = is_v ? head * 64 + 8 * fq : head * 96 + (is_rope ? 64 + 16 * (fq & 1) : 8 * fq);
        const float inv_cnt = is_rope ? (1.0f / 32.0f) : (1.0f / 64.0f), sc = isq ? MLA_SCALE : 1.0f;
        const bool st_ok = !is_rope || fq < 2;
        const int rowb = u.pm * BM + wr * 64 + fr;
#pragma unroll
        for (int ai = 0; ai < 2; ++ai)
#pragma unroll
            for (int m = 0; m < 4; ++m) {
                const int row = rowb + ai * HALF + m * 16;
                float ss = 0.f;
#pragma unroll
                for (int j = 0; j < 4; ++j) ss += acc[ai][0][m][0][j] * acc[ai][0][m][0][j] + acc[ai][0][m][1][j] * acc[ai][0][m][1][j] + acc[ai][1][m][0][j] * acc[ai][1][m][0][j] + acc[ai][1][m][1][j] * acc[ai][1][m][1][j];
                ss += ::swz<16>(ss); ss = ::x32_sum(ss);
                float rs = rsqrtf(ss * inv_cnt + 1e-6f) * sc; rs = is_v ? 1.0f : rs;
                const int pos = row & 2047, pp = rot ? ((fq & 1) ? (pos & 63) : (pos >> 6)) : 0;
                const float* rt = rope + pp * 16;
                bf16_t* dst = obase + (unsigned)(row * ostride + ocol);
#pragma unroll
                for (int n = 0; n < 2; ++n) {
                    const f32x4 g1 = *(const f32x4*)(g + 4 * n), g2 = *(const f32x4*)(g + sbj + 4 * n);
                    const f32x4 t0 = *(const f32x4*)(rt + 8 * n), t1 = *(const f32x4*)(rt + 8 * n + 4);
                    const f32x4 c = (f32x4){t0[0], t0[2], t1[0], t1[2]}, s = (f32x4){t0[1], t0[3], t1[1], t1[3]};
                    const f32x4 a1 = acc[ai][0][m][n] * rs * g1, a2 = acc[ai][1][m][n] * rs * g2;
                    const f32x4 o1 = a1 * c - a2 * s, o2 = a1 * s + a2 * c;
                    if (st_ok) { u32x2 w; w.x = cvt_pk_bf16(o1[0], o1[1]); w.y = cvt_pk_bf16(o1[2], o1[3]); *(u32x2*)(dst + 4 * n) = w;
                        w.x = cvt_pk_bf16(o2[0], o2[1]); w.y = cvt_pk_bf16(o2[2], o2[3]); *(u32x2*)(dst + sbj + 4 * n) = w; }
                }
                asm volatile("" ::: "memory");
            }
    }
};

template <class Epi, class Sched>
__device__ __forceinline__ void gemm_phase(PG8_LAS unsigned char* lds, const Gemm g, const Sched& S, const Epi& E) {
    const int tid = otid(), wid = __builtin_amdgcn_readfirstlane(tid >> 6), lane = tid & 63, wr = wid >> 2, wc = wid & 3, fr = lane & 15, fq = lane >> 4;
    const int K = g.K, nt = K / BK;
    unsigned voffA[2], voffB[2];
#pragma unroll
    for (int i = 0; i < 2; ++i) { int R, C; stage_rc(tid * 16 + i * 8192, R, C); const int Rb = Epi::PERM ? ((R & ~31) + perm32(R & 31)) : R;
        voffA[i] = (unsigned)(R * K + C) * 2u; voffB[i] = (unsigned)(Rb * K + C) * 2u; }
    const size_t kstep = (size_t)(BK * 2);
    const size_t hstep = (size_t)HALF * K * 2;
    const size_t tstep = 2 * hstep;
    const unsigned ldsw = (unsigned)wid * 1024u;
    const int foff = lds_byte(fr, fq * 8); const int ua = wr * 8192, ub = wc * 4096;
#define PG8_SA(b, h) (((b) * 2 + (h)) * HTB)
#define PG8_SB(b, h) ((4 + (b) * 2 + (h)) * HTB)
#define PG8_STAGE(bufoff, gbase, voff) do { _Pragma("unroll") for (int _i = 0; _i < 2; ++_i) \
        __builtin_amdgcn_global_load_lds((const unsigned*)((const char*)(gbase) + (voff)[_i]), (PG8_LAS unsigned*)(lds + (bufoff) + ldsw + _i * 8192), 16, 0, 0); } while (0)
#define PG8_LDA(dst, b, h) do { int aoff; asm volatile("v_add_u32 %0, %1, %2" : "=v"(aoff) : "s"(ua), "v"(foff)); _Pragma("unroll") for (int m = 0; m < 4; ++m) _Pragma("unroll") for (int k = 0; k < 2; ++k) dst[m][k] = *(const PG8_LAS bf16x8*)(lds + PG8_SA(b, h) + aoff + m * 2048 + k * 1024); } while (0)
#define PG8_LDB(dst, b, h) do { int boff; asm volatile("v_add_u32 %0, %1, %2" : "=v"(boff) : "s"(ub), "v"(foff)); _Pragma("unroll") for (int n = 0; n < 2; ++n) _Pragma("unroll") for (int k = 0; k < 2; ++k) dst[n][k] = *(const PG8_LAS bf16x8*)(lds + PG8_SB(b, h) + boff + n * 2048 + k * 1024); } while (0)
#define PG8_MMA(ai, bj, At, Bt) do { __builtin_amdgcn_s_setprio(1); _Pragma("unroll") for (int m = 0; m < 4; ++m) _Pragma("unroll") for (int n = 0; n < 2; ++n) _Pragma("unroll") for (int k = 0; k < 2; ++k) \
        acc[ai][bj][m][n] = __builtin_amdgcn_mfma_f32_16x16x32_bf16(Bt[n][k], At[m][k], acc[ai][bj][m][n], 0, 0, 0); __builtin_amdgcn_s_setprio(0); } while (0)
#define PG8_WAIT_V(n) asm volatile("s_waitcnt vmcnt(" #n ")" ::: "memory")
#define PG8_WAIT_L(n) asm volatile("s_waitcnt lgkmcnt(" #n ")" ::: "memory")
#define PG8_BAR __builtin_amdgcn_s_barrier()
#define PG8_SCHED __builtin_amdgcn_sched_barrier(0)
    Unit cur, nxt; int ui = 0;
    if (!S.next(0, cur)) return;
    f32x4 acc[2][2][4][2];
#pragma unroll
    for (int a = 0; a < 2; ++a)
#pragma unroll
        for (int b = 0; b < 2; ++b)
#pragma unroll
            for (int m = 0; m < 4; ++m)
#pragma unroll
                for (int n = 0; n < 2; ++n) acc[a][b][m][n] = (f32x4){0.f, 0.f, 0.f, 0.f};
    bf16x8 At[4][2], B0[2][2], B1[2][2];
    int cnt = nt;
    size_t ck = 0;
    if constexpr (Sched::SPLIT) { int k0_, kn_; S.krange(cur, nt, k0_, kn_); cnt = kn_; ck = (size_t)k0_ * kstep; }
    const char* cA = (const char*)g.A + (size_t)cur.pm * tstep + ck; const char* cB = (const char*)g.Bt + (size_t)cur.pn * tstep + ck;
    S.a_ready(cur);
    PG8_STAGE(PG8_SB(0, 0), cB, voffB); PG8_STAGE(PG8_SA(0, 0), cA, voffA); PG8_STAGE(PG8_SB(0, 1), cB + hstep, voffB); PG8_STAGE(PG8_SA(0, 1), cA + hstep, voffA);
    if (wr == 1) PG8_BAR;
    PG8_WAIT_V(4); PG8_BAR;
    PG8_STAGE(PG8_SB(1, 0), cB + kstep, voffB); PG8_STAGE(PG8_SA(1, 0), cA + kstep, voffA); PG8_STAGE(PG8_SB(1, 1), cB + hstep + kstep, voffB);
    PG8_WAIT_V(6); PG8_BAR;
    for (;;) {
        const bool has_next = S.next(ui + 1, nxt);
        int ncnt = nt; size_t nk = 0;
        if constexpr (Sched::SPLIT) { if (has_next) { int k0_, kn_; S.krange(nxt, nt, k0_, kn_); ncnt = kn_; nk = (size_t)k0_ * kstep; } }
        const char* nA = has_next ? (const char*)g.A + (size_t)nxt.pm * tstep + nk : cA; const char* nB = has_next ? (const char*)g.Bt + (size_t)nxt.pn * tstep + nk : cB;
        for (int t = 0; t < cnt; t += 2) {
            const bool last = (t == cnt - 2);
            const char* a1 = cA + (size_t)(t + 1) * kstep;
            const char* a2 = last ? nA : cA + (size_t)(t + 2) * kstep; const char* b2 = last ? nB : cB + (size_t)(t + 2) * kstep;
            const char* a3 = a2 + kstep; const char* b3 = b2 + kstep;
            if (last && has_next) S.a_ready(nxt);
            PG8_LDB(B0, 0, 0); PG8_SCHED; PG8_LDA(At, 0, 0); PG8_STAGE(PG8_SA(1, 1), a1 + hstep, voffA);
            PG8_WAIT_L(8); PG8_BAR; PG8_WAIT_L(0); PG8_MMA(0, 0, At, B0); PG8_BAR; PG8_SCHED;
            PG8_LDB(B1, 0, 1); PG8_STAGE(PG8_SB(0, 0), b2, voffB);
            PG8_BAR; PG8_WAIT_L(0); PG8_MMA(0, 1, At, B1); PG8_BAR;
            PG8_LDA(At, 0, 1); PG8_STAGE(PG8_SA(0, 0), a2, voffA);
            PG8_BAR; PG8_WAIT_L(0); PG8_MMA(1, 0, At, B0); PG8_BAR; PG8_SCHED;
            PG8_STAGE(PG8_SB(0, 1), b2 + hstep, voffB);
            PG8_WAIT_V(6); PG8_BAR; PG8_MMA(1, 1, At, B1); PG8_BAR;
            PG8_LDB(B0, 1, 0); PG8_SCHED; PG8_LDA(At, 1, 0); PG8_STAGE(PG8_SA(0, 1), a2 + hstep, voffA);
            PG8_WAIT_L(8); PG8_BAR; PG8_WAIT_L(0); PG8_MMA(0, 0, At, B0); PG8_BAR; PG8_SCHED;
            PG8_LDB(B1, 1, 1); PG8_STAGE(PG8_SB(1, 0), b3, voffB);
            PG8_BAR; PG8_WAIT_L(0); PG8_MMA(0, 1, At, B1); PG8_BAR;
            PG8_LDA(At, 1, 1); PG8_STAGE(PG8_SA(1, 0), a3, voffA);
            PG8_BAR; PG8_WAIT_L(0); PG8_MMA(1, 0, At, B0); PG8_BAR; PG8_SCHED;
            PG8_STAGE(PG8_SB(1, 1), b3 + hstep, voffB);
            PG8_WAIT_V(6); PG8_BAR; PG8_MMA(1, 1, At, B1); PG8_BAR;
        }
        if constexpr (!Epi::AFTER_DRAIN) { E(acc, cur, wr, wc, fr, fq); S.done(cur); }
        if (!has_next) break;
#pragma unroll
        for (int a = 0; a < 2; ++a)
#pragma unroll
            for (int b = 0; b < 2; ++b)
#pragma unroll
                for (int m = 0; m < 4; ++m)
#pragma unroll
                    for (int n = 0; n < 2; ++n) acc[a][b][m][n] = (f32x4){0.f, 0.f, 0.f, 0.f};
        cur = nxt; cA = nA; cB = nB; cnt = ncnt; ++ui;
    }
    PG8_WAIT_V(0);
    if (wr == 0) PG8_BAR;
    PG8_BAR;
    if constexpr (Epi::AFTER_DRAIN) { E.fused(acc, cur, wr, wc, fr, fq, lds, wid, lane); S.done(cur); }
#undef PG8_SA
#undef PG8_SB
#undef PG8_STAGE
#undef PG8_LDA
#undef PG8_LDB
#undef PG8_MMA
#undef PG8_WAIT_V
#undef PG8_WAIT_L
#undef PG8_BAR
#undef PG8_SCHED
}
}


__device__ __forceinline__ void p0_adaln(const Params& P, float* lf) {
    const int tid = otid(), lane = tid & 63, wave = tid >> 6;
    float* sc = lf;
    float* red = lf + 17 * 1024;
    const float* c = PIN(1); const float* cctx = PIN(3);
    const float* ada_w = PIN(4); const float* ada_b = PIN(5);
    float* mod = (float*)(PWS + WS_MOD);
    for (int i = tid; i < 17 * 1024; i += 512) { const int r = i >> 10, k = i & 1023; const float v = r < 16 ? c[r * 1024 + k] : cctx[k]; sc[i] = v / (1.0f + expf(-v)); }
    __syncthreads();
    for (int item = blockIdx.x; item < 768; item += gridDim.x) {
        const int l = item / 192, j0 = (item % 192) * 32;
        const int col = lane & 31, kh = lane >> 5;
        const float* w = ada_w + (size_t)l * 1024 * 6144 + j0 + col;
        float acc[17];
#pragma unroll
        for (int r = 0; r < 17; ++r) acc[r] = 0.f;
        const int kb = wave * 128 + kh * 64;
        for (int k0 = kb; k0 < kb + 64; k0 += 32) {
            float wv[32];
#pragma unroll
            for (int e = 0; e < 32; ++e) wv[e] = w[(size_t)(k0 + e) * 6144];
#pragma unroll
            for (int e = 0; e < 32; ++e)
#pragma unroll
                for (int r = 0; r < 17; ++r) acc[r] += sc[r * 1024 + k0 + e] * wv[e];
        }
#pragma unroll
        for (int r = 0; r < 17; ++r) red[(wave * 17 + r) * 64 + lane] = acc[r];
        __syncthreads();
        for (int i = tid; i < 17 * 32; i += 512) {
            const int r = i >> 5, jj = i & 31; float s = 0.f;
#pragma unroll
            for (int w8 = 0; w8 < 8; ++w8) s += red[(w8 * 17 + r) * 64 + jj] + red[(w8 * 17 + r) * 64 + 32 + jj];
            mod[(size_t)(l * 17 + r) * 6144 + j0 + jj] = s + ada_b[l * 6144 + j0 + jj];
        }
        __syncthreads();
    }
}

__device__ __forceinline__ float cvt_src(const Params& P, int mat, int l, int n, int k) {
    if (mat == 0) return n < NIN ? PIN(8)[((size_t)l * 1024 + k) * NIN + n] : 0.f;
    if (mat == 1) { const int kk = k < 1024 ? k : k - 256; return PIN(25)[((size_t)l * 1024 + kk) * 1024 + n]; }
    if (mat == 2) { const int t = n >> 8, w = n & 255, col = t * 128 + (w & 127);
        const float* src = (w >> 7) ? PIN(27) : PIN(26); return src[((size_t)l * 1024 + k) * FF + col]; }
    if (mat == 3) return PIN(28)[((size_t)l * FF + k) * 1024 + n];
    const int pn = n >> 8, tc = n & 255, wc = (tc >> 5) & 3, ss = ((tc >> 7) << 5) | (8 * ((tc >> 2) & 3) + 4 * ((tc >> 4) & 1) + (tc & 3));
    const int head = (pn % 3) * 2 + (wc >> 1), kind = wc & 1;
    if (pn < 3) {
        if (k >= 256) return 0.f;
        int col;
        if (kind == 0) col = head * 96 + ss;
        else { const int bj = ss >> 5, s5 = ss & 31; if (s5 >= 16) return 0.f; col = head * 96 + 64 + (s5 < 8 ? s5 + 8 * bj : 16 + (s5 - 8) + 8 * bj); }
        return PIN(13)[((size_t)l * 256 + k) * 576 + col];
    }
    if (k < 256) return 0.f;
    return PIN(15)[((size_t)l * 128 + (k - 256)) * 768 + head * 128 + kind * 64 + ss];
}
__device__ __forceinline__ const float* cvt_ptr(int mat, int l, int n, int k) {
    if (mat == 0) return n < NIN ? PIN(8) + ((size_t)l * 1024 + k) * NIN + n : nullptr;
    if (mat == 1) { const int kk = k < 1024 ? k : k - 256; return PIN(25) + ((size_t)l * 1024 + kk) * 1024 + n; }
    if (mat == 2) { const int t = n >> 8, w = n & 255, col = t * 128 + (w & 127);
        const float* s = (w >> 7) ? PIN(27) : PIN(26); return s + ((size_t)l * 1024 + k) * FF + col; }
    if (mat == 3) return PIN(28) + ((size_t)l * FF + k) * 1024 + n;
    const int pn = n >> 8, tc = n & 255, wc = (tc >> 5) & 3, ss = ((tc >> 7) << 5) | (8 * ((tc >> 2) & 3) + 4 * ((tc >> 4) & 1) + (tc & 3));
    const int head = (pn % 3) * 2 + (wc >> 1), kind = wc & 1;
    if (pn < 3) {
        if (k >= 256) return nullptr;
        int col;
        if (kind == 0) col = head * 96 + ss;
        else { const int bj = ss >> 5, s5 = ss & 31; if (s5 >= 16) return nullptr; col = head * 96 + 64 + (s5 < 8 ? s5 + 8 * bj : 16 + (s5 - 8) + 8 * bj); }
        return PIN(13) + ((size_t)l * 256 + k) * 576 + col;
    }
    if (k < 256) return nullptr;
    return PIN(15) + ((size_t)l * 128 + (k - 256)) * 768 + head * 128 + kind * 64 + ss;
}
__device__ __forceinline__ void p0_convert(const Params& P, float* tile) {
    const int tid = otid();
    if (blockIdx.x == 0) { float* rt = (float*)(PWS + WS_ROPE); const int p = tid >> 3, f = tid & 7;
        const float ang = (float)p * expf(-(float)f * (9.210340371976184f * 0.125f)); rt[tid * 2] = cosf(ang); rt[tid * 2 + 1] = sinf(ang); if (tid < 64) rt[1024 + tid] = 1.0f; }
    constexpr int NT = 4 * 3152;
    const int nl = tid & 63, kq = tid >> 6;
    for (int it = blockIdx.x * 4; it < NT; it += gridDim.x * 4) {
        float4 v[4][2];
#pragma unroll
        for (int j = 0; j < 4; ++j) {
            const int item = it + j < NT ? it + j : NT - 1;
            const int l = item / 3152; int r = item % 3152; int mat, ntk;
            if (r < 576) { mat = 0; ntk = 16; } else if (r < 896) { r -= 576; mat = 1; ntk = 20; } else if (r < 2304) { r -= 896; mat = 2; ntk = 16; }
            else if (r < 3008) { r -= 2304; mat = 3; ntk = 44; } else { r -= 3008; mat = 4; ntk = 6; }
            const int n0 = (r / ntk) * 64, k0 = (r % ntk) * 64;
#pragma unroll
            for (int e = 0; e < 2; ++e) { const float* p_ = cvt_ptr(mat, l, n0 + (tid & 15) * 4, k0 + (tid >> 4) + 32 * e); v[j][e] = p_ ? *(const float4*)p_ : make_float4(0.f, 0.f, 0.f, 0.f); }
        }
#pragma unroll
        for (int j = 0; j < 4; ++j)
#pragma unroll
            for (int e = 0; e < 2; ++e) { float* t_ = tile + j * 4160 + ((tid >> 4) + 32 * e) * 65 + (tid & 15) * 4; t_[0] = v[j][e].x; t_[1] = v[j][e].y; t_[2] = v[j][e].z; t_[3] = v[j][e].w; }
        __syncthreads();
#pragma unroll
        for (int j = 0; j < 4; ++j) {
            if (it + j < NT) {
                const int item = it + j;
                const int l = item / 3152; int r = item % 3152; int ntk, Kd; bf16_t* dst;
                if (r < 576) { ntk = 16; Kd = 1024; dst = (bf16_t*)(PWS + WS_WIN) + (size_t)l * NINP * 1024; }
                else if (r < 896) { r -= 576; ntk = 20; Kd = OW; dst = (bf16_t*)(PWS + WS_WOUT) + (size_t)l * 1024 * OW; }
                else if (r < 2304) { r -= 896; ntk = 16; Kd = 1024; dst = (bf16_t*)(PWS + WS_WGU) + (size_t)l * 2 * FF * 1024; }
                else if (r < 3008) { r -= 2304; ntk = 44; Kd = FF; dst = (bf16_t*)(PWS + WS_WD) + (size_t)l * 1024 * FF; }
                else { r -= 3008; ntk = 6; Kd = 384; dst = (bf16_t*)(PWS + WS_WUP) + (size_t)l * 1536 * 384; }
                const int n0 = (r / ntk) * 64, k0 = (r % ntk) * 64;
                const int kp = tid & 31, nh = tid >> 5;
#pragma unroll
                for (int e = 0; e < 4; ++e) { const int nl2 = nh * 4 + e;
                    *(unsigned*)(dst + (size_t)(n0 + nl2) * Kd + k0 + 2 * kp) = pk2(tile[j * 4160 + (2 * kp) * 65 + nl2], tile[j * 4160 + (2 * kp + 1) * 65 + nl2]); }
            }
        }
        __syncthreads();
    }
}

__device__ __forceinline__ void p_norm(const float* hlat, const float* hctx, const float* g, const float* modl, int sh_off, int sc_off, bf16_t* A, int M,
                                       const float* part, const float* cgate, float* hcout) {
    const int tid = otid(), lane = tid & 63, wave = tid >> 6;
    const int stride = gridDim.x * 8;
    int row = obid() * 8 + wave;
    float4 v[4], nv[4];
#define PN_LOAD(dst, rw) do { const float* s_ = (rw) < NLAT ? hlat + (size_t)(rw) * 1024 : hctx + (size_t)((rw) - NLAT) * 1024; \
        _Pragma("unroll") for (int i = 0; i < 4; ++i) dst[i] = *(const float4*)(s_ + i * 256 + lane * 4); } while (0)
    if (row < M) PN_LOAD(v, row);
    while (row < M) {
        const int nrow = row + stride;
        if (nrow < M) PN_LOAD(nv, nrow);
        const int r = row < NLAT ? (row >> 11) : 16;
        float ss = 0.f;
#pragma unroll
        for (int i = 0; i < 4; ++i) {
            if (part != nullptr && row >= NLAT) {
                const size_t po = (size_t)(row - NLAT) * 1024 + i * 256 + lane * 4;
                const float4 p0 = *(const float4*)(part + po), p1 = *(const float4*)(part + (size_t)4096 * 1024 + po), cg = *(const float4*)(cgate + i * 256 + lane * 4);
                v[i].x += cg.x * (p0.x + p1.x); v[i].y += cg.y * (p0.y + p1.y); v[i].z += cg.z * (p0.z + p1.z); v[i].w += cg.w * (p0.w + p1.w);
                *(float4*)(hcout + po) = v[i];
            }
            ss += v[i].x * v[i].x + v[i].y * v[i].y + v[i].z * v[i].z + v[i].w * v[i].w; }
        ss = wave_sum(ss);
        const float rstd = rsqrtf(ss * (1.0f / 1024.0f) + EPS);
        const float* mr = modl + (size_t)r * 6144;
#pragma unroll
        for (int i = 0; i < 4; ++i) {
            const int k = i * 256 + lane * 4;
            const float4 gg = *(const float4*)(g + k), scv = *(const float4*)(mr + sc_off + k), shv = *(const float4*)(mr + sh_off + k);
            const float o0 = v[i].x * rstd * gg.x * (1.0f + scv.x) + shv.x, o1 = v[i].y * rstd * gg.y * (1.0f + scv.y) + shv.y;
            const float o2 = v[i].z * rstd * gg.z * (1.0f + scv.z) + shv.z, o3 = v[i].w * rstd * gg.w * (1.0f + scv.w) + shv.w;
            uint2 w; w.x = pk2(o0, o1); w.y = pk2(o2, o3);
            *(uint2*)(A + (size_t)row * 1024 + k) = w;
        }
#pragma unroll
        for (int i = 0; i < 4; ++i) v[i] = nv[i];
        row = nrow;
    }
#undef PN_LOAD
}

__device__ __forceinline__ float rope32(float z, int lane, int tokpos) {
    const int l5 = lane & 31, half = l5 >> 4, idx = l5 & 15, f = idx & 7;
    const int pos = half ? (tokpos & 63) : (tokpos >> 6);
    const float inv = expf(-(float)f * (9.210340371976184f * 0.125f));
    const float ang = (float)pos * inv;
    const float cs = cosf(ang), sn = sinf(ang);
    const float p = swz<8>(z);
    return idx < 8 ? z * cs - p * sn : p * sn + z * cs;
}
__device__ __forceinline__ void unpack8(const uint4 r, float (&v)[8]) { v[0] = bflo(r.x); v[1] = bfhi(r.x); v[2] = bflo(r.y); v[3] = bfhi(r.y); v[4] = bflo(r.z); v[5] = bfhi(r.z); v[6] = bflo(r.w); v[7] = bfhi(r.w); }
__device__ __forceinline__ uint4 pack8(const float (&v)[8]) { uint4 w; w.x = pk2(v[0], v[1]); w.y = pk2(v[2], v[3]); w.z = pk2(v[4], v[5]); w.w = pk2(v[6], v[7]); return w; }
__device__ __forceinline__ void p3_prep(const Params& P, int l) {
    const int tid = otid(), lane = tid & 63, wave = tid >> 6;
    bf16_t* U = (bf16_t*)(PWS + WS_U);
    bf16_t* MK = (bf16_t*)(PWS + WS_MK); bf16_t* A2 = (bf16_t*)(PWS + WS_A2);
    const float* rope = (const float*)(PWS + WS_ROPE);
    const int sub = lane & 7;
    float gA[8], gB[8], gC[8];
    { const float* nqg = PIN(9) + l * 64 + sub * 8; const float* nkg = PIN(10) + l * 64 + sub * 8;
#pragma unroll
      for (int j = 0; j < 8; ++j) { gA[j] = lane < 48 ? nqg[j] * NA_QSCALE : nkg[j]; gB[j] = nkg[j]; }
      const float* gc = lane < 32 ? PIN(12) + l * 256 + lane * 8 : (lane < 48 ? PIN(14) + l * 128 + (lane - 32) * 8 : PIN(17) + l * 96 + 64 + ((lane - 48) & 3) * 8);
#pragma unroll
      for (int j = 0; j < 8; ++j) gC[j] = gc[j]; }
    for (int row = obid() * 8 + wave; row < MTOK; row += gridDim.x * 8) {
        bf16_t* u = U + (size_t)row * NINP;
        const bool latent = row < NLAT;
        const uint4 ra = *(const uint4*)(u + lane * 8);
        const uint4 rb = *(const uint4*)(u + 512 + (lane & 31) * 8);
        const uint4 rc = *(const uint4*)(u + OCQ + (lane < 52 ? lane : 51) * 8);
        float v[8];
        unpack8(ra, v);
        { float s = 0.f;
#pragma unroll
          for (int j = 0; j < 8; ++j) s += v[j] * v[j];
          s += swz<1>(s); s += swz<2>(s); s += swz<4>(s);
          const float rs = rsqrtf(s * (1.0f / 64.0f) + EPS);
#pragma unroll
          for (int j = 0; j < 8; ++j) v[j] = v[j] * rs * gA[j];
          *(uint4*)(u + lane * 8) = pack8(v); }
        unpack8(rb, v);
        { float s = 0.f;
#pragma unroll
          for (int j = 0; j < 8; ++j) s += v[j] * v[j];
          s += swz<1>(s); s += swz<2>(s); s += swz<4>(s);
          const float rs = rsqrtf(s * (1.0f / 64.0f) + EPS);
#pragma unroll
          for (int j = 0; j < 8; ++j) v[j] = v[j] * rs * gB[j];
          if (lane < 32) *(uint4*)(u + 512 + lane * 8) = pack8(v); }
        unpack8(rc, v);
        { float s = 0.f;
#pragma unroll
          for (int j = 0; j < 8; ++j) s += v[j] * v[j];
          s += swz<1>(s); const float s2 = s + swz<2>(s); const float s3 = s2 + swz<4>(s2); const float s4 = s3 + swz<8>(s3); const float s5 = s4 + swz<16>(s4);
          const float ms = lane < 32 ? s5 * (1.0f / 256.0f) : (lane < 48 ? s4 * (1.0f / 128.0f) : s2 * (1.0f / 32.0f));
          const float rs = rsqrtf(ms + EPS);
#pragma unroll
          for (int j = 0; j < 8; ++j) v[j] = v[j] * rs * gC[j];
          float pv[8];
#pragma unroll
          for (int j = 0; j < 8; ++j) pv[j] = swz<1>(v[j]);
          if (lane < 48) { *(uint4*)(A2 + (size_t)row * 384 + lane * 8) = pack8(v); }
          else if (lane < 52) {
              const int q4 = lane - 48;
              if (latent) {
                  const int pos = row & 2047, pp = (q4 < 2) ? (pos >> 6) : (pos & 63);
                  const float* rt = rope + pp * 16;
#pragma unroll
                  for (int j = 0; j < 8; ++j) { const float c = rt[2 * j], sn = rt[2 * j + 1];
                      v[j] = (q4 & 1) ? pv[j] * sn + v[j] * c : v[j] * c - pv[j] * sn; }
              }
              const uint4 w = pack8(v);
#pragma unroll
              for (int h = 0; h < 6; ++h) *(uint4*)(MK + (size_t)row * 576 + h * 96 + 64 + q4 * 8) = w;
          } }
    }
}

__device__ __forceinline__ float sigmoid_f(float x) { return 1.0f / (1.0f + expf(-x)); }
__device__ __forceinline__ float gelu_tanh(float x) { return 0.5f * x * (1.0f + tanhf(0.7978845608028654f * (x + 0.044715f * x * x * x))); }
__device__ __forceinline__ void p3_lru(const Params& P, int l, float* lf, int item) {
    const int tid = otid();
    const int b = item >> 3, dir = (item >> 2) & 1, hd = item & 3;
    float* wA = lf; float* wX = lf + 4096; float* xc = lf + 8192; float* av = lf + 12288; float* uv = lf + 16384;
    const float* w_a = PIN(20) + (size_t)((l * 2 + dir) * 4 + hd) * 4096;
    const float* w_x = PIN(22) + (size_t)((l * 2 + dir) * 4 + hd) * 4096;
    __syncthreads();
    for (int i = tid; i < 4096; i += 512) { wA[i] = w_a[i]; wX[i] = w_x[i]; }
    const int j = tid & 63, tq = tid >> 6, c = hd * 64 + j;
    const float ba = PIN(21)[(l * 2 + dir) * 256 + c], bx = PIN(23)[(l * 2 + dir) * 256 + c];
    const float lam = PIN(24)[(l * 2 + dir) * 256 + c];
    const float sp = log1pf(expf(-lam));
    float cw[4];
#pragma unroll
    for (int jj = 0; jj < 4; ++jj) cw[jj] = PIN(18)[(l * 4 + jj) * 256 + c];
    const float cb = PIN(19)[l * 256 + c];
    const bf16_t* U = (const bf16_t*)(PWS + WS_U);
    bf16_t* O = (bf16_t*)(PWS + WS_AO);
    float h = 0.f;
    __syncthreads();
    for (int seg = 0; seg < 2; ++seg) {
        const int base = seg == 0 ? NLAT + b * CTXL : b * SEQ;
        const int len = seg == 0 ? CTXL : SEQ, nch = len >> 6;
        for (int ci = 0; ci < nch; ++ci) {
            const int t0 = (dir ? nch - 1 - ci : ci) * 64;
#pragma unroll
            for (int e = 0; e < 8; ++e) {
                const int t = t0 + tq * 8 + e; float s = cb;
#pragma unroll
                for (int jj = 0; jj < 4; ++jj) { const int tt = t - 1 + jj; if (tt >= 0 && tt < len) s += cw[jj] * bf2f(U[(size_t)(base + tt) * NINP + OLX + c]); }
                xc[(tq * 8 + e) * 64 + j] = s;
            }
            __syncthreads();
            float ga[8], gx[8];
#pragma unroll
            for (int e = 0; e < 8; ++e) { ga[e] = 0.f; gx[e] = 0.f; }
            for (int i = 0; i < 64; ++i) {
                const float a = wA[i * 64 + j], x = wX[i * 64 + j];
#pragma unroll
                for (int e = 0; e < 8; ++e) { const float v = xc[(tq * 8 + e) * 64 + i]; ga[e] += v * a; gx[e] += v * x; }
            }
#pragma unroll
            for (int e = 0; e < 8; ++e) {
                const int tl = tq * 8 + e;
                const float xv = xc[tl * 64 + j];
                const float la = -8.0f * sigmoid_f(ga[e] + ba) * sp;
                av[tl * 64 + j] = expf(la);
                uv[tl * 64 + j] = sqrtf(-expm1f(2.0f * la)) * sigmoid_f(gx[e] + bx) * xv;
            }
            __syncthreads();
            if (tid < 64) {
                if (!dir) { for (int tl = 0; tl < 64; ++tl) { h = av[tl * 64 + j] * h + uv[tl * 64 + j]; uv[tl * 64 + j] = h; } }
                else { for (int tl = 63; tl >= 0; --tl) { h = av[tl * 64 + j] * h + uv[tl * 64 + j]; uv[tl * 64 + j] = h; } }
            }
            __syncthreads();
#pragma unroll
            for (int e = 0; e < 8; ++e) {
                const int tl = tq * 8 + e; const size_t row = (size_t)(base + t0 + tl);
                const float g = bf2f(U[row * NINP + OLG + c]);
                O[row * OW + 768 + dir * 256 + c] = f2bf(gelu_tanh(g) * uv[tl * 64 + j]);
            }
            __syncthreads();
        }
    }
}


typedef short s16x4 __attribute__((ext_vector_type(4)));
typedef short bf16x8_t __attribute__((ext_vector_type(8)));
typedef float f32x4_t __attribute__((ext_vector_type(4)));
typedef unsigned u32x4_t __attribute__((ext_vector_type(4)));
typedef unsigned u32x2_t __attribute__((ext_vector_type(2)));
#define LASP __attribute__((address_space(3)))
template <int DQK>
__device__ __forceinline__ void flash_item(unsigned char* smem, const bf16_t* Q, int qs, const bf16_t* K0, const bf16_t* V0, int n0, const bf16_t* K1, const bf16_t* V1, int n1, int ks, int vs, bf16_t* Oo, int os, float shift) {
    constexpr int KT = 128, NKG = KT / 16, NKP = KT / 32;
    constexpr int KR = DQK * 2 + 16, VR = 144, KCH = DQK / 8, NKK = DQK / 32;
    constexpr int VOFF = 32768;
    constexpr int NKC = KCH / 4;
    constexpr int NVC = 2;
    static_assert(KT * KR <= VOFF, "flash tile geometry");
    const int tid = otid(), lane = tid & 63, wave = tid >> 6, fr = lane & 15, fq = lane >> 4;
    LASP unsigned char* ls = (LASP unsigned char*)smem;
    bf16x8_t qf[2][NKK];
#pragma unroll
    for (int qg = 0; qg < 2; ++qg)
#pragma unroll
        for (int kk = 0; kk < NKK; ++kk) qf[qg][kk] = *(const bf16x8_t*)(Q + (size_t)(wave * 32 + qg * 16 + fr) * qs + kk * 32 + fq * 8);
    f32x4_t o[4][2];
#pragma unroll
    for (int dg = 0; dg < 4; ++dg) { o[dg][0] = (f32x4_t){0.f, 0.f, 0.f, 0.f}; o[dg][1] = (f32x4_t){0.f, 0.f, 0.f, 0.f}; }
    float lsum[2] = {0.f, 0.f};
    const float nsh = -shift;
    const int ntiles = (n0 + n1) / KT;
    u32x4_t kreg[NKC], vreg[NVC];
#define FL_LOAD(key0) do { const bf16_t* Kb = (key0) < n0 ? K0 + (size_t)(key0) * ks : K1 + (size_t)((key0) - n0) * ks; \
        const bf16_t* Vb = (key0) < n0 ? V0 + (size_t)(key0) * vs : V1 + (size_t)((key0) - n0) * vs; \
        _Pragma("unroll") for (int c = 0; c < NKC; ++c) kreg[c] = *(const u32x4_t*)(Kb + (size_t)(tid >> 2) * ks + ((tid & 3) + 4 * c) * 8); \
        _Pragma("unroll") for (int c = 0; c < NVC; ++c) vreg[c] = *(const u32x4_t*)(Vb + (size_t)((tid >> 3) + 64 * c) * vs + (tid & 7) * 8); } while (0)
    FL_LOAD(0);
    for (int t = 0; t < ntiles; ++t) {
        __syncthreads();
#pragma unroll
        for (int c = 0; c < NKC; ++c) *(LASP u32x4_t*)(ls + (tid >> 2) * KR + ((tid & 3) + 4 * c) * 16) = kreg[c];
#pragma unroll
        for (int c = 0; c < NVC; ++c) *(LASP u32x4_t*)(ls + VOFF + ((tid >> 3) + 64 * c) * VR + (tid & 7) * 16) = vreg[c];
        __syncthreads();
        f32x4_t s[NKG][2];
#pragma unroll
        for (int kg = 0; kg < NKG; ++kg) { s[kg][0] = (f32x4_t){nsh, nsh, nsh, nsh}; s[kg][1] = (f32x4_t){nsh, nsh, nsh, nsh}; }
#pragma unroll
        for (int kk = 0; kk < NKK; ++kk) {
#pragma unroll
            for (int kg = 0; kg < NKG; ++kg) {
                const bf16x8_t kf = *(const LASP bf16x8_t*)(ls + (kg * 16 + fr) * KR + (kk * 32 + fq * 8) * 2);
                s[kg][0] = __builtin_amdgcn_mfma_f32_16x16x32_bf16(kf, qf[0][kk], s[kg][0], 0, 0, 0);
                s[kg][1] = __builtin_amdgcn_mfma_f32_16x16x32_bf16(kf, qf[1][kk], s[kg][1], 0, 0, 0);
            }
            asm volatile("" ::: "memory");
        }
        if (t + 1 < ntiles) FL_LOAD((t + 1) * KT);
#pragma unroll
        for (int qg = 0; qg < 2; ++qg) {
            float ps = 0.f;
#pragma unroll
            for (int kg = 0; kg < NKG; ++kg)
#pragma unroll
                for (int j = 0; j < 4; ++j) { const float p = __builtin_amdgcn_exp2f(s[kg][qg][j]); s[kg][qg][j] = p; ps += p; }
            lsum[qg] += ps;
        }
#pragma unroll
        for (int kp = 0; kp < NKP; ++kp) {
            bf16x8_t pb[2];
#pragma unroll
            for (int qg = 0; qg < 2; ++qg) {
                const f32x4_t a = s[2 * kp][qg], b = s[2 * kp + 1][qg];
                u32x4_t pk; pk.x = pg8::cvt_pk_bf16(a[0], a[1]); pk.y = pg8::cvt_pk_bf16(a[2], a[3]); pk.z = pg8::cvt_pk_bf16(b[0], b[1]); pk.w = pg8::cvt_pk_bf16(b[2], b[3]);
                pb[qg] = __builtin_bit_cast(bf16x8_t, pk);
            }
#pragma unroll
            for (int dg = 0; dg < 4; ++dg) {
                LASP unsigned char* va = ls + VOFF + (32 * kp + 4 * fq + (fr >> 2)) * VR + (16 * dg + 4 * (fr & 3)) * 2;
                const s16x4 v0 = __builtin_amdgcn_ds_read_tr16_b64_v4i16((LASP s16x4*)va);
                const s16x4 v1 = __builtin_amdgcn_ds_read_tr16_b64_v4i16((LASP s16x4*)(va + 16 * VR));
                const bf16x8_t vf = __builtin_shufflevector(v0, v1, 0, 1, 2, 3, 4, 5, 6, 7);
                o[dg][0] = __builtin_amdgcn_mfma_f32_16x16x32_bf16(vf, pb[0], o[dg][0], 0, 0, 0);
                o[dg][1] = __builtin_amdgcn_mfma_f32_16x16x32_bf16(vf, pb[1], o[dg][1], 0, 0, 0);
            }
        }
    }
#undef FL_LOAD
#pragma unroll
    for (int qg = 0; qg < 2; ++qg) {
        float l = lsum[qg]; l += swz<16>(l); l = x32_sum(l);
        const float inv = 1.0f / l;
        bf16_t* orow = Oo + (size_t)(wave * 32 + qg * 16 + fr) * os + fq * 4;
#pragma unroll
        for (int dg = 0; dg < 4; ++dg) {
            u32x2_t w; w.x = pg8::cvt_pk_bf16(o[dg][qg][0] * inv, o[dg][qg][1] * inv); w.y = pg8::cvt_pk_bf16(o[dg][qg][2] * inv, o[dg][qg][3] * inv);
            *(u32x2_t*)(orow + dg * 16) = w;
        }
    }
}

__device__ __forceinline__ float softplus_neg(float lam) { const float x = __expf(-lam);
    return x < 0.06f ? x * (1.0f - x * (0.5f - x * ((1.0f / 3.0f) - x * (0.25f - x * 0.2f)))) : __logf(1.0f + x); }
__device__ __forceinline__ float one_minus_exp(float y) {
    const float p = -y * (1.0f + y * (0.5f + y * ((1.0f / 6.0f) + y * ((1.0f / 24.0f) + y * ((1.0f / 120.0f) + y * ((1.0f / 720.0f) + y * (1.0f / 5040.0f)))))));
    return y > -0.25f ? p : 1.0f - __expf(y); }
__device__ __forceinline__ void p3_lru2(int l, unsigned char* smem, int item) {
    constexpr int O_XS = 0, O_XC = 9216, O_A = 25600, O_U = 41984, O_SP = 58368, O_SH = 60416, O_HC = 62464;
    const int tid = otid(), lane = tid & 63, wave = tid >> 6, fr = lane & 15, fq = lane >> 4;
    const int b = item >> 3, dir = (item >> 2) & 1, hd = item & 3;
    LASP unsigned char* ls = (LASP unsigned char*)smem;
    LASP float* xcf = (LASP float*)(ls + O_XC); LASP float* Aa = (LASP float*)(ls + O_A); LASP float* Uu = (LASP float*)(ls + O_U);
    LASP float* sP = (LASP float*)(ls + O_SP); LASP float* sH = (LASP float*)(ls + O_SH); LASP float* hc = (LASP float*)(ls + O_HC);
    const bf16_t* U = (const bf16_t*)(PWS + WS_U);
    bf16_t* O = (bf16_t*)(PWS + WS_AO);
    const int c8 = tid & 7, tr = tid >> 3;
    float cw[4][8], cb[8];
    { const float* cwp = PIN(18) + (size_t)l * 4 * 256 + hd * 64 + c8 * 8; const float* cbp = PIN(19) + l * 256 + hd * 64 + c8 * 8;
#pragma unroll
      for (int jj = 0; jj < 4; ++jj)
#pragma unroll
          for (int e = 0; e < 8; ++e) cw[jj][e] = cwp[jj * 256 + e];
#pragma unroll
      for (int e = 0; e < 8; ++e) cb[e] = cbp[e]; }
    bf16x8_t wf[2];
    { const float* wsrc = (fr < 8 ? PIN(20) : PIN(22)) + (size_t)((l * 2 + dir) * 4 + hd) * 4096 + 8 * wave + (fr & 7);
#pragma unroll
      for (int kk = 0; kk < 2; ++kk) { u32x4_t pk;
          const int ci = 32 * kk + 8 * fq;
          pk.x = pk2(wsrc[(ci + 0) * 64], wsrc[(ci + 1) * 64]); pk.y = pk2(wsrc[(ci + 2) * 64], wsrc[(ci + 3) * 64]);
          pk.z = pk2(wsrc[(ci + 4) * 64], wsrc[(ci + 5) * 64]); pk.w = pk2(wsrc[(ci + 6) * 64], wsrc[(ci + 7) * 64]);
          wf[kk] = __builtin_bit_cast(bf16x8_t, pk); } }
    const int cg = (l * 2 + dir) * 256 + hd * 64 + 8 * wave + (fr & 7);
    const float ba_ = PIN(21)[cg], bx_ = PIN(23)[cg];
    const float sp = softplus_neg(PIN(24)[cg]);
    const int chl = 8 * wave + (fr & 7);
    __syncthreads();
    if (tid < 128) hc[tid] = 0.f;
    int par = 0;
    for (int seg = 0; seg < 2; ++seg) {
        const int base = seg == 0 ? NLAT + b * CTXL : b * SEQ;
        const int len = seg == 0 ? CTXL : SEQ, nch = len >> 6;
        const bf16_t* Ub = U + (size_t)base * NINP + OLX + hd * 64 + c8 * 8;
        u32x4_t nx[4];
#define LRU_LOAD(tq0) do { _Pragma("unroll") for (int jj = 0; jj < 4; ++jj) { const int tt = (tq0) + tr - 1 + jj; \
            nx[jj] = (tt >= 0 && tt < len) ? *(const u32x4_t*)(Ub + (size_t)tt * NINP) : (u32x4_t){0u, 0u, 0u, 0u}; } } while (0)
        LRU_LOAD((dir ? nch - 1 : 0) * 64);
        for (int ci = 0; ci < nch; ++ci) {
            const int t0 = (dir ? nch - 1 - ci : ci) * 64;
            { float xv[8];
#pragma unroll
              for (int e = 0; e < 8; ++e) xv[e] = cb[e];
#pragma unroll
              for (int jj = 0; jj < 4; ++jj) { const u32x4_t w = nx[jj];
                  xv[0] += cw[jj][0] * bflo(w.x); xv[1] += cw[jj][1] * bfhi(w.x); xv[2] += cw[jj][2] * bflo(w.y); xv[3] += cw[jj][3] * bfhi(w.y);
                  xv[4] += cw[jj][4] * bflo(w.z); xv[5] += cw[jj][5] * bfhi(w.z); xv[6] += cw[jj][6] * bflo(w.w); xv[7] += cw[jj][7] * bfhi(w.w); }
              u32x4_t pk; pk.x = pk2(xv[0], xv[1]); pk.y = pk2(xv[2], xv[3]); pk.z = pk2(xv[4], xv[5]); pk.w = pk2(xv[6], xv[7]);
              *(LASP u32x4_t*)(ls + O_XS + tr * 144 + c8 * 16) = pk;
              *(LASP f32x4_t*)(xcf + tr * 64 + c8 * 8) = (f32x4_t){xv[0], xv[1], xv[2], xv[3]};
              *(LASP f32x4_t*)(xcf + tr * 64 + c8 * 8 + 4) = (f32x4_t){xv[4], xv[5], xv[6], xv[7]}; }
            if (ci + 1 < nch) LRU_LOAD((dir ? nch - 2 - ci : ci + 1) * 64);
            float lgv[8];
#pragma unroll
            for (int e = 0; e < 8; ++e) { const int o = wave * 8 + e, tl = dir ? 63 - o : o;
                lgv[e] = bf2f(U[(size_t)(base + t0 + tl) * NINP + OLG + hd * 64 + lane]); }
            __syncthreads();
            { f32x4_t ga[4];
#pragma unroll
              for (int rg = 0; rg < 4; ++rg) ga[rg] = (f32x4_t){0.f, 0.f, 0.f, 0.f};
#pragma unroll
              for (int kk = 0; kk < 2; ++kk)
#pragma unroll
                  for (int rg = 0; rg < 4; ++rg) {
                      const bf16x8_t xa = *(const LASP bf16x8_t*)(ls + O_XS + (rg * 16 + fr) * 144 + (kk * 32 + fq * 8) * 2);
                      ga[rg] = __builtin_amdgcn_mfma_f32_16x16x32_bf16(xa, wf[kk], ga[rg], 0, 0, 0);
                  }
              const bool lo = fr < 8;
#pragma unroll
              for (int rg = 0; rg < 4; ++rg) {
                  const float r0 = swz<8>(lo ? ga[rg][2] : ga[rg][0]), r1 = swz<8>(lo ? ga[rg][3] : ga[rg][1]);
#pragma unroll
                  for (int jj = 0; jj < 2; ++jj) {
                      const float rcv = jj ? r1 : r0;
                      const float gA_ = lo ? ga[rg][jj] : rcv, gX_ = lo ? rcv : ga[rg][2 + jj];
                      const int tl = rg * 16 + fq * 4 + (lo ? jj : 2 + jj);
                      const float sa = __builtin_amdgcn_rcpf(1.0f + __builtin_amdgcn_exp2f(-(gA_ + ba_) * LOG2E));
                      const float sx = __builtin_amdgcn_rcpf(1.0f + __builtin_amdgcn_exp2f(-(gX_ + bx_) * LOG2E));
                      const float la = -8.0f * sa * sp;
                      const float a = __builtin_amdgcn_exp2f(la * LOG2E), mult = __builtin_amdgcn_sqrtf(one_minus_exp(2.0f * la));
                      Aa[tl * 64 + chl] = a; Uu[tl * 64 + chl] = mult * sx * xcf[tl * 64 + chl];
                  }
              } }
            __syncthreads();
            float hl[8], pp[8];
            { float h = 0.f, p = 1.f;
#pragma unroll
              for (int e = 0; e < 8; ++e) { const int o = wave * 8 + e, tl = dir ? 63 - o : o;
                  const float a = Aa[tl * 64 + lane], u = Uu[tl * 64 + lane];
                  h = a * h + u; p *= a; hl[e] = h; pp[e] = p; }
              sP[wave * 64 + lane] = p; sH[wave * 64 + lane] = h; }
            __syncthreads();
            { float cin = hc[par * 64 + lane];
              for (int s2 = 0; s2 < wave; ++s2) cin = sP[s2 * 64 + lane] * cin + sH[s2 * 64 + lane];
#pragma unroll
              for (int e = 0; e < 8; ++e) { const int o = wave * 8 + e, tl = dir ? 63 - o : o;
                  const float h = hl[e] + pp[e] * cin;
                  const size_t row = (size_t)(base + t0 + tl);
                  const float g = lgv[e];
                  const float gl = g * __builtin_amdgcn_rcpf(1.0f + __builtin_amdgcn_exp2f(-2.3022082f * (g + 0.044715f * g * g * g)));
                  O[row * OW + 768 + dir * 256 + hd * 64 + lane] = f2bf(gl * h);
                  if (e == 7 && wave == 7) hc[(par ^ 1) * 64 + lane] = h; } }
            par ^= 1;
        }
#undef LRU_LOAD
    }
    __syncthreads();
}


__device__ __forceinline__ void na_item(unsigned char* smem, const bf16_t* U, const float* rpb_l, bf16_t* O, int b, int rp, int hp, float shift) {
    constexpr int KR = 144, HSZ = 27648, O_VL = 9216, O_KC = 18432, O_VC = 23040, BUF = 2 * HSZ, O_BIAS = 2 * BUF;
    const int tid = otid(), lane = tid & 63, wave = tid >> 6, fr = lane & 15, fq = lane >> 4;
    const int hh = wave >> 2, qg = wave & 3, h = 2 * hp + hh;
    LASP unsigned char* ls = (LASP unsigned char*)smem;
    LASP float* bias = (LASP float*)(ls + O_BIAS);
    const int rA = 2 * rp, rB = rA + 1;
    const int rsA = min(max(rA - 4, 0), 24), rsB = min(max(rB - 4, 0), 24), dB = rsB - rsA, nst = dB + 8;
    const int kcol0 = min(max(16 * qg - 8, 0), 32);
    const int qc = 16 * qg + fr, cs = min(max(qc - 8, 0), 48);
    const size_t qrowA = (size_t)b * SEQ + rA * 64 + qc, qrowB = qrowA + 64;
    bf16x8_t qfA[2], qfB[2];
#pragma unroll
    for (int kk = 0; kk < 2; ++kk) { qfA[kk] = *(const bf16x8_t*)(U + qrowA * NINP + OQ + h * 64 + kk * 32 + fq * 8); qfB[kk] = *(const bf16x8_t*)(U + qrowB * NINP + OQ + h * 64 + kk * 32 + fq * 8); }
    f32x4_t oA[4], oB[4];
#pragma unroll
    for (int dg = 0; dg < 4; ++dg) { oA[dg] = (f32x4_t){0.f, 0.f, 0.f, 0.f}; oB[dg] = (f32x4_t){0.f, 0.f, 0.f, 0.f}; }
    float lA = 0.f, lB = 0.f;
    const float nsh = -shift;
    const int srow = tid >> 3, sch = tid & 7;
    const int crow = (tid & 255) >> 3, cisv = tid >> 8;
    const size_t latbase = ((size_t)b * SEQ + (size_t)rsA * 64 + srow) * NINP + sch * 8;
    const size_t ctxbase = ((size_t)NLAT + b * CTXL + crow) * NINP + (cisv ? OV : OKK) + sch * 8;
    u32x4_t rg[6];
#define NA_LOAD(step) do { _Pragma("unroll") for (int e = 0; e < 2; ++e) { const int hx = 2 * hp + e; \
        rg[3 * e + 0] = *(const u32x4_t*)(U + latbase + (size_t)(step) * 64 * NINP + OKK + hx * 64); \
        rg[3 * e + 1] = *(const u32x4_t*)(U + latbase + (size_t)(step) * 64 * NINP + OV + hx * 64); \
        if ((step) < 8) rg[3 * e + 2] = *(const u32x4_t*)(U + ctxbase + (size_t)(step) * 32 * NINP + hx * 64); } } while (0)
#define NA_STORE(step) do { LASP unsigned char* sb_ = ls + ((step) & 1) * BUF; _Pragma("unroll") for (int e = 0; e < 2; ++e) { \
        *(LASP u32x4_t*)(sb_ + e * HSZ + srow * KR + sch * 16) = rg[3 * e + 0]; \
        *(LASP u32x4_t*)(sb_ + e * HSZ + O_VL + srow * KR + sch * 16) = rg[3 * e + 1]; \
        if ((step) < 8) *(LASP u32x4_t*)(sb_ + e * HSZ + (cisv ? O_VC : O_KC) + crow * KR + sch * 16) = rg[3 * e + 2]; } } while (0)
    NA_LOAD(0);
    __syncthreads();
    for (int i2 = tid; i2 < 2 * 15 * 32; i2 += 512) { const int e = i2 / 480, rr = (i2 % 480) >> 5, x = i2 & 31;
        bias[i2] = x < 31 ? rpb_l[((2 * hp + e) * 15 + rr) * 31 + x] * LOG2E : 0.f; }
    NA_STORE(0);
    NA_LOAD(1);
    __syncthreads();
    for (int i = 0; i < nst; ++i) {
        if (i + 1 < nst) NA_STORE(i + 1);
        if (i + 2 < nst) NA_LOAD(i + 2);
        LASP unsigned char* base = ls + (i & 1) * BUF + hh * HSZ;
        const bool hasctx = i < 8, latA = i < 8, latB = (i >= dB);
        f32x4_t sA[4], sB[4];
#pragma unroll
        for (int g = 0; g < 4; ++g) { sA[g] = (f32x4_t){nsh, nsh, nsh, nsh}; sB[g] = (f32x4_t){nsh, nsh, nsh, nsh}; }
#pragma unroll
        for (int kk = 0; kk < 2; ++kk) {
#pragma unroll
            for (int g = 0; g < 2; ++g) {
                const bf16x8_t kl = *(const LASP bf16x8_t*)(base + (kcol0 + 16 * g + fr) * KR + (kk * 32 + fq * 8) * 2);
                sA[g] = __builtin_amdgcn_mfma_f32_16x16x32_bf16(kl, qfA[kk], sA[g], 0, 0, 0);
                sB[g] = __builtin_amdgcn_mfma_f32_16x16x32_bf16(kl, qfB[kk], sB[g], 0, 0, 0);
                const bf16x8_t kc = *(const LASP bf16x8_t*)(base + O_KC + (16 * g + fr) * KR + (kk * 32 + fq * 8) * 2);
                sA[2 + g] = __builtin_amdgcn_mfma_f32_16x16x32_bf16(kc, qfA[kk], sA[2 + g], 0, 0, 0);
                sB[2 + g] = __builtin_amdgcn_mfma_f32_16x16x32_bf16(kc, qfB[kk], sB[2 + g], 0, 0, 0);
            }
        }
        const int relA = rsA + i - rA + 7, relB = relA - 1;
        const int brA = min(max(relA, 0), 14), brB = min(max(relB, 0), 14);
#pragma unroll
        for (int g = 0; g < 2; ++g)
#pragma unroll
            for (int j = 0; j < 4; ++j) {
                const int kc = kcol0 + 16 * g + 4 * fq + j;
                const bool valid = (kc >= cs) && (kc < cs + 16);
                const int idx = min(max(kc - qc + 15, 0), 30);
                sA[g][j] = (valid && latA) ? sA[g][j] + bias[(hh * 15 + brA) * 32 + idx] : -INFINITY;
                sB[g][j] = (valid && latB) ? sB[g][j] + bias[(hh * 15 + brB) * 32 + idx] : -INFINITY;
            }
        if (!hasctx) {
#pragma unroll
            for (int g = 2; g < 4; ++g) { sA[g] = (f32x4_t){-INFINITY, -INFINITY, -INFINITY, -INFINITY}; sB[g] = sA[g]; }
        }
        { float psA = 0.f, psB = 0.f;
#pragma unroll
          for (int g = 0; g < 4; ++g)
#pragma unroll
              for (int j = 0; j < 4; ++j) { const float pa = __builtin_amdgcn_exp2f(sA[g][j]); sA[g][j] = pa; psA += pa;
                                            const float pb_ = __builtin_amdgcn_exp2f(sB[g][j]); sB[g][j] = pb_; psB += pb_; }
          lA += psA; lB += psB; }
#pragma unroll
        for (int kp = 0; kp < 2; ++kp) {
            u32x4_t pk;
            pk.x = pg8::cvt_pk_bf16(sA[2 * kp][0], sA[2 * kp][1]); pk.y = pg8::cvt_pk_bf16(sA[2 * kp][2], sA[2 * kp][3]); pk.z = pg8::cvt_pk_bf16(sA[2 * kp + 1][0], sA[2 * kp + 1][1]); pk.w = pg8::cvt_pk_bf16(sA[2 * kp + 1][2], sA[2 * kp + 1][3]);
            const bf16x8_t pbA = __builtin_bit_cast(bf16x8_t, pk);
            pk.x = pg8::cvt_pk_bf16(sB[2 * kp][0], sB[2 * kp][1]); pk.y = pg8::cvt_pk_bf16(sB[2 * kp][2], sB[2 * kp][3]); pk.z = pg8::cvt_pk_bf16(sB[2 * kp + 1][0], sB[2 * kp + 1][1]); pk.w = pg8::cvt_pk_bf16(sB[2 * kp + 1][2], sB[2 * kp + 1][3]);
            const bf16x8_t pbB = __builtin_bit_cast(bf16x8_t, pk);
            LASP unsigned char* vb = kp == 0 ? base + O_VL + (kcol0 + 4 * fq + (fr >> 2)) * KR : base + O_VC + (4 * fq + (fr >> 2)) * KR;
#pragma unroll
            for (int dg = 0; dg < 4; ++dg) {
                LASP unsigned char* va = vb + (16 * dg + 4 * (fr & 3)) * 2;
                const s16x4 v0 = __builtin_amdgcn_ds_read_tr16_b64_v4i16((LASP s16x4*)va);
                const s16x4 v1 = __builtin_amdgcn_ds_read_tr16_b64_v4i16((LASP s16x4*)(va + 16 * KR));
                const bf16x8_t vf = __builtin_shufflevector(v0, v1, 0, 1, 2, 3, 4, 5, 6, 7);
                oA[dg] = __builtin_amdgcn_mfma_f32_16x16x32_bf16(vf, pbA, oA[dg], 0, 0, 0);
                oB[dg] = __builtin_amdgcn_mfma_f32_16x16x32_bf16(vf, pbB, oB[dg], 0, 0, 0);
            }
        }
        __syncthreads();
    }
#undef NA_LOAD
#undef NA_STORE
    { float l = lA; l += swz<16>(l); l = x32_sum(l); const float inv = 1.0f / l;
      bf16_t* orow = O + qrowA * OW + h * 64 + fq * 4;
#pragma unroll
      for (int dg = 0; dg < 4; ++dg) { u32x2_t w; w.x = pg8::cvt_pk_bf16(oA[dg][0] * inv, oA[dg][1] * inv); w.y = pg8::cvt_pk_bf16(oA[dg][2] * inv, oA[dg][3] * inv); *(u32x2_t*)(orow + dg * 16) = w; } }
    { float l = lB; l += swz<16>(l); l = x32_sum(l); const float inv = 1.0f / l;
      bf16_t* orow = O + qrowB * OW + h * 64 + fq * 4;
#pragma unroll
      for (int dg = 0; dg < 4; ++dg) { u32x2_t w; w.x = pg8::cvt_pk_bf16(oB[dg][0] * inv, oB[dg][1] * inv); w.y = pg8::cvt_pk_bf16(oB[dg][2] * inv, oB[dg][3] * inv); *(u32x2_t*)(orow + dg * 16) = w; } }
}

template <int DQK, bool BIAS>
__device__ __forceinline__ void attn_keys(const float (&q)[DQK], const bf16_t* K, int kstride, const bf16_t* V, int vstride, int n, const float* bias, float& m, float& l, float (&acc)[64]) {
    for (int j = 0; j < n; ++j) {
        const uint4* kp = (const uint4*)(K + (size_t)j * kstride);
        float s = BIAS ? bias[j] * LOG2E : 0.f;
#pragma unroll
        for (int c = 0; c < DQK / 8; ++c) { const uint4 w = kp[c];
            s += q[8 * c + 0] * bflo(w.x) + q[8 * c + 1] * bfhi(w.x) + q[8 * c + 2] * bflo(w.y) + q[8 * c + 3] * bfhi(w.y)
               + q[8 * c + 4] * bflo(w.z) + q[8 * c + 5] * bfhi(w.z) + q[8 * c + 6] * bflo(w.w) + q[8 * c + 7] * bfhi(w.w); }
        if (s > m) { const float f = exp2f(m - s); l *= f;
#pragma unroll
            for (int d = 0; d < 64; ++d) acc[d] *= f;
            m = s; }
        const float p = exp2f(s - m); l += p;
        const uint4* vp = (const uint4*)(V + (size_t)j * vstride);
#pragma unroll
        for (int c = 0; c < 8; ++c) { const uint4 w = vp[c];
            acc[8 * c + 0] += p * bflo(w.x); acc[8 * c + 1] += p * bfhi(w.x); acc[8 * c + 2] += p * bflo(w.y); acc[8 * c + 3] += p * bfhi(w.y);
            acc[8 * c + 4] += p * bflo(w.z); acc[8 * c + 5] += p * bfhi(w.z); acc[8 * c + 6] += p * bflo(w.w); acc[8 * c + 7] += p * bfhi(w.w); }
    }
}
template <int DQK> __device__ __forceinline__ void load_q(float (&q)[DQK], const bf16_t* src) {
#pragma unroll
    for (int c = 0; c < DQK / 8; ++c) { const uint4 w = ((const uint4*)src)[c];
        q[8 * c + 0] = bflo(w.x); q[8 * c + 1] = bfhi(w.x); q[8 * c + 2] = bflo(w.y); q[8 * c + 3] = bfhi(w.y);
        q[8 * c + 4] = bflo(w.z); q[8 * c + 5] = bfhi(w.z); q[8 * c + 6] = bflo(w.w); q[8 * c + 7] = bfhi(w.w); }
}
__device__ __forceinline__ void store_o(bf16_t* dst, const float (&acc)[64], float l) {
    const float r = 1.0f / l;
#pragma unroll
    for (int c = 0; c < 8; ++c) { uint4 w; w.x = pk2(acc[8 * c] * r, acc[8 * c + 1] * r); w.y = pk2(acc[8 * c + 2] * r, acc[8 * c + 3] * r);
        w.z = pk2(acc[8 * c + 4] * r, acc[8 * c + 5] * r); w.w = pk2(acc[8 * c + 6] * r, acc[8 * c + 7] * r); ((uint4*)dst)[c] = w; }
}
__device__ __forceinline__ void p4_attn(const Params& P, int l, bool last, unsigned char* smem) {
    for (int it = obid(); it < 128; it += gridDim.x) p3_lru2(l, smem, it);
    const unsigned x0 = (unsigned)__builtin_amdgcn_s_getreg((3 << 11) | 20) & 7u;
    float shift_mla, shift_nac, shift_nal;
    { const int ln = otid() & 63;
      float gq = fmaxf(fabsf(PIN(16)[l * 96 + ln]), fabsf(PIN(16)[l * 96 + 64 + (ln & 31)])), gk = fmaxf(fabsf(PIN(17)[l * 96 + ln]), fabsf(PIN(17)[l * 96 + 64 + (ln & 31)]));
      float nq_ = fabsf(PIN(9)[l * 64 + ln]), nk_ = fabsf(PIN(10)[l * 64 + ln]);
      gq = fmaxf(gq, swz<1>(gq)); gq = fmaxf(gq, swz<2>(gq)); gq = fmaxf(gq, swz<4>(gq)); gq = fmaxf(gq, swz<8>(gq)); gq = fmaxf(gq, swz<16>(gq)); gq = x32_max(gq);
      gk = fmaxf(gk, swz<1>(gk)); gk = fmaxf(gk, swz<2>(gk)); gk = fmaxf(gk, swz<4>(gk)); gk = fmaxf(gk, swz<8>(gk)); gk = fmaxf(gk, swz<16>(gk)); gk = x32_max(gk);
      nq_ = fmaxf(nq_, swz<1>(nq_)); nq_ = fmaxf(nq_, swz<2>(nq_)); nq_ = fmaxf(nq_, swz<4>(nq_)); nq_ = fmaxf(nq_, swz<8>(nq_)); nq_ = fmaxf(nq_, swz<16>(nq_)); nq_ = x32_max(nq_);
      nk_ = fmaxf(nk_, swz<1>(nk_)); nk_ = fmaxf(nk_, swz<2>(nk_)); nk_ = fmaxf(nk_, swz<4>(nk_)); nk_ = fmaxf(nk_, swz<8>(nk_)); nk_ = fmaxf(nk_, swz<16>(nk_)); nk_ = x32_max(nk_);
      shift_mla = __int_as_float(__builtin_amdgcn_readfirstlane(__float_as_int(fminf(96.0f * MLA_SCALE * gq * gk * 1.01f + 0.5f, 60.0f))));
      shift_nac = __int_as_float(__builtin_amdgcn_readfirstlane(__float_as_int(fminf(64.0f * NA_QSCALE * nq_ * nk_ * 1.01f + 0.5f, 60.0f))));
      float bm = 0.f;
      for (int i = ln; i < 6 * 15 * 31; i += 64) bm = fmaxf(bm, fabsf(PIN(11)[(size_t)l * 6 * 15 * 31 + i]));
      bm = fmaxf(bm, swz<1>(bm)); bm = fmaxf(bm, swz<2>(bm)); bm = fmaxf(bm, swz<4>(bm)); bm = fmaxf(bm, swz<8>(bm)); bm = fmaxf(bm, swz<16>(bm)); bm = x32_max(bm);
      shift_nal = __int_as_float(__builtin_amdgcn_readfirstlane(__float_as_int(fminf(64.0f * NA_QSCALE * nq_ * nk_ * 1.01f + 0.5f + bm * LOG2E, 60.0f)))); }
    const int nq = last ? 192 : 216;
    for (int pr = 0; pr < 8; ++pr) {
        const int q = (int)((x0 + pr) & 7u);
        for (;;) {
            volatile LASP unsigned* slot = (volatile LASP unsigned*)((LASP unsigned char*)smem + 131072 + 8);
            __syncthreads();
            if (otid() == 0) *slot = __hip_atomic_fetch_add((unsigned*)(PWS + WS_Q) + (size_t)(l * 8 + q) * 64, 1u, __ATOMIC_RELAXED, __HIP_MEMORY_SCOPE_AGENT);
            __syncthreads();
            const int i = __builtin_amdgcn_readfirstlane((int)*slot);
            if (i >= nq) break;
            unsigned char* ws = PWS;
            const bf16_t* U = (const bf16_t*)(ws + WS_U);
            bf16_t* O = (bf16_t*)(ws + WS_AO);
            if (i >= 96 && i < 192) {
                const int j = i - 96, bp = q * 6 + (j >> 4), r = j & 15;
                na_item(smem, U, PIN(11) + (size_t)l * 6 * 15 * 31, O, bp / 3, r, bp % 3, shift_nal);
            } else if (i >= 204) {
                const int bh = q * 12 + (i - 204), b = bh / 6, h = bh % 6;
                const size_t c0 = (size_t)NLAT + b * CTXL;
                flash_item<64>(smem, U + c0 * NINP + OQ + h * 64, NINP, U + c0 * NINP + OKK + h * 64, U + c0 * NINP + OV + h * 64, CTXL, nullptr, nullptr, 0, NINP, NINP, O + c0 * OW + h * 64, OW, shift_nac);
            } else {
                const bf16_t* MQ = (const bf16_t*)(ws + WS_MQ); const bf16_t* MK = (const bf16_t*)(ws + WS_MK); const bf16_t* MV = (const bf16_t*)(ws + WS_MV);
                const bool lat = i < 96;
                const int bh = q * 12 + (lat ? (i >> 3) : (i - 192)), b = bh / 6, h = bh % 6;
                const size_t c0 = (size_t)NLAT + b * CTXL, l0 = (size_t)b * SEQ;
                const size_t q0 = lat ? l0 + (i & 7) * 256 : c0;
                flash_item<96>(smem, MQ + q0 * 576 + h * 96, 576, MK + c0 * 576 + h * 96, MV + c0 * 384 + h * 64, CTXL, MK + l0 * 576 + h * 96, MV + l0 * 384 + h * 64, lat ? SEQ : 0, 576, 384,
                               O + q0 * OW + 384 + h * 64, OW, shift_mla);
            }
        }
    }
}

#define XB_TMO      128
#define XB_XCNT(j)  (256  + 64 * (j))
#define XB_XSUB(j)  (1280 + 64 * (j))
#define XB_XGEN(j)  (2304 + 64 * (j))
#define XB_TOP      3328
#define XB_TOPGEN   3392
#define XCD_BAR_WORDS 3456
#define XB_SPIN_CAP (1u << 18)
#define LAS __attribute__((address_space(3)))

__device__ __forceinline__ unsigned xb_ld(unsigned* p)              { return __hip_atomic_load(p, __ATOMIC_RELAXED, __HIP_MEMORY_SCOPE_AGENT); }
__device__ __forceinline__ unsigned xb_add(unsigned* p, unsigned v) { return __hip_atomic_fetch_add(p, v, __ATOMIC_RELAXED, __HIP_MEMORY_SCOPE_AGENT); }
__device__ __forceinline__ unsigned xb_xcc_id() { return (unsigned)__builtin_amdgcn_s_getreg((3 << 11) | 20) & 0xFu; }
#define XB_SPIN(cond, bar) do { unsigned _sp = 0; while (cond) { __builtin_amdgcn_s_sleep(1); \
    if ((++_sp & 255u) == 0u) { if (xb_ld(&(bar)[XB_TMO])) break; if (_sp > XB_SPIN_CAP) { atomicAdd(&(bar)[XB_TMO], 1u); break; } } } } while (0)

struct XcdBarrier {
    unsigned* bar; unsigned x;
    volatile LAS unsigned* st;
};

__device__ __forceinline__ XcdBarrier xcd_barrier_post(unsigned* bar, volatile LAS unsigned* st) {
    XcdBarrier b; b.bar = bar; b.x = xb_xcc_id(); b.st = st;
    if (threadIdx.x == 0) (void)xb_add(&bar[XB_XCNT(b.x)], 1u);
    return b;
}
__device__ __forceinline__ void xcd_barrier_complete(unsigned* bar, unsigned x, unsigned& nloc, unsigned& nx) {
    const unsigned G = gridDim.x * gridDim.y * gridDim.z;
    unsigned sum, cnt, mine, sp = 0u;
    for (;;) {
        sum = 0u; cnt = 0u; mine = 0u;
#pragma unroll
        for (unsigned j = 0; j < 16; ++j) { const unsigned c = xb_ld(&bar[XB_XCNT(j)]); sum += c; cnt += (c > 0u) ? 1u : 0u; mine = (j == x) ? c : mine; }
        if (sum == G) break;
        __builtin_amdgcn_s_sleep(1);
        if ((++sp & 255u) == 0u) { if (xb_ld(&bar[XB_TMO])) break; if (sp > XB_SPIN_CAP) { atomicAdd(&bar[XB_TMO], 1u); break; } }
    }
    nloc = mine > 0u ? mine : 1u; nx = cnt > 0u ? cnt : 1u;
}

__device__ __forceinline__ void xcd_barrier(const XcdBarrier& b) {
    asm volatile("s_waitcnt vmcnt(0)" ::: "memory");
    __syncthreads();
    if (threadIdx.x == 0) {
        unsigned* bar = b.bar;
        __builtin_amdgcn_s_waitcnt(0);
        unsigned nloc = b.st[0], nx = b.st[1];
        if (nloc == 0u) { xcd_barrier_complete(bar, b.x, nloc, nx); b.st[0] = nloc; b.st[1] = nx; }
        const unsigned old = xb_add(&bar[XB_XSUB(b.x)], 1u);
        const unsigned gen = old / nloc;
        if (old + 1u == (gen + 1u) * nloc) {
            __builtin_amdgcn_fence(__ATOMIC_RELEASE, "agent");
            asm volatile("s_waitcnt vmcnt(0)" ::: "memory");
            const unsigned og = xb_add(&bar[XB_TOP], 1u);
            const unsigned tg = og / nx;
            if (og + 1u == (tg + 1u) * nx) xb_add(&bar[XB_TOPGEN], 1u);
            else XB_SPIN(xb_ld(&bar[XB_TOPGEN]) == tg, bar);
            __builtin_amdgcn_fence(__ATOMIC_ACQUIRE, "agent");
            xb_add(&bar[XB_XGEN(b.x)], 1u);
            asm volatile("s_waitcnt vmcnt(0)" ::: "memory");
        } else {
            XB_SPIN(xb_ld(&bar[XB_XGEN(b.x)]) == gen, bar);
            __builtin_amdgcn_fence(__ATOMIC_ACQUIRE, "agent");
            asm volatile("s_waitcnt vmcnt(0)" ::: "memory");
        }
    }
    __syncthreads();
}


__global__ void __launch_bounds__(512, 2) hybrid_fwd(Params P) {
    extern __shared__ __attribute__((aligned(16))) unsigned char smem[];
    cg::grid_group grid = cg::this_grid();
    float* lf = (float*)smem;
    PG8_LAS unsigned char* lds = (PG8_LAS unsigned char*)smem;
    const int G = gridDim.x, bid = blockIdx.x;
    float* mod = (float*)(PWS + WS_MOD);
    float* hc = (float*)(PWS + WS_HC);
    bf16_t* AO = (bf16_t*)(PWS + WS_AO);
    bf16_t* U = (bf16_t*)(PWS + WS_U);
    bf16_t* HID = (bf16_t*)(PWS + WS_HID);

    unsigned* barw = (unsigned*)(PWS + WS_BAR);
    if (bid == 0) for (int i = otid(); i < XCD_BAR_WORDS + 4 * 8 * 64; i += 512) barw[i] = 0u;
    if (otid() < 4) ((LASP unsigned*)smem)[32768 + otid()] = 0u;
    __syncthreads();
    p0_adaln(P, lf);
    __syncthreads();
    p0_convert(P, lf);
    grid.sync();
    const XcdBarrier xbar = xcd_barrier_post(barw, (volatile LASP unsigned*)((LASP unsigned char*)smem + 131072));
#define GSYNC() xcd_barrier(xbar)

    for (int l = 0; l < DEPTH; ++l) {
        const bool last = (l == DEPTH - 1);
        const float* modl = mod + (size_t)l * 17 * 6144;
        const float* hl_in = l == 0 ? PIN(0) : POUT;
        const float* hc_in = l == 0 ? PIN(2) : hc;
        const int Mf = last ? NLAT : MTOK;

        p_norm(hl_in, hc_in, PIN(6) + l * 1024, modl, 0, 1024, AO, MTOK, l > 0 ? (const float*)(PWS + WS_MK) : nullptr, mod + (size_t)((l > 0 ? l - 1 : 0) * 17 + 16) * 6144 + 5 * 1024, hc);
        GSYNC();
        { pg8::Gemm g{AO, (const bf16_t*)(PWS + WS_WIN) + (size_t)l * NINP * 1024, MTOK, NINP, 1024};
          pg8::StaticOrder S; S.init(MTOK, NINP, G, obid());
          pg8::EpiBf16 E{U, NINP};
          pg8::gemm_phase<pg8::EpiBf16, pg8::StaticOrder>(lds, g, S, E); }
        GSYNC();
        p3_prep(P, l);
        GSYNC();
        { pg8::Gemm g{(const bf16_t*)(PWS + WS_A2), (const bf16_t*)(PWS + WS_WUP) + (size_t)l * 1536 * 384, MTOK, 1536, 384};
          pg8::UpOrder S; S.init(MTOK, 1536, G, obid());
          pg8::EpiMla E{l};
          pg8::gemm_phase<pg8::EpiMla, pg8::UpOrder>(lds, g, S, E); }
        GSYNC();
        p4_attn(P, l, last, smem);
        GSYNC();
        { pg8::Gemm g{AO, (const bf16_t*)(PWS + WS_WOUT) + (size_t)l * 1024 * OW, Mf, 1024, OW};
          pg8::CtxSplitOrder S; S.init(!last, G, obid());
          pg8::EpiRes E{hl_in, POUT, hc_in, hc, modl + 2 * 1024, (float*)(PWS + WS_MK)};
          pg8::gemm_phase<pg8::EpiRes, pg8::CtxSplitOrder>(lds, g, S, E); }
        GSYNC();
        p_norm(POUT, hc_in, PIN(7) + l * 1024, modl, 3 * 1024, 4 * 1024, AO, Mf, last ? nullptr : (const float*)(PWS + WS_MK), modl + 16 * 6144 + 2 * 1024, hc);
        GSYNC();
        { pg8::Gemm g{AO, (const bf16_t*)(PWS + WS_WGU) + (size_t)l * 2 * FF * 1024, Mf, 2 * FF, 1024};
          pg8::StaticOrder S; S.init(Mf, 2 * FF, G, obid());
          pg8::EpiSwiglu E{HID, FF};
          pg8::gemm_phase<pg8::EpiSwiglu, pg8::StaticOrder>(lds, g, S, E); }
        GSYNC();
        { pg8::Gemm g{HID, (const bf16_t*)(PWS + WS_WD) + (size_t)l * 1024 * FF, Mf, 1024, FF};
          pg8::CtxSplitOrder S; S.init(!last, G, obid());
          pg8::EpiRes E{POUT, POUT, hc, hc, modl + 5 * 1024, (float*)(PWS + WS_MK)};
          pg8::gemm_phase<pg8::EpiRes, pg8::CtxSplitOrder>(lds, g, S, E); }
        GSYNC();
    }
}

extern "C" void kernel_launch(void* const* d_in, const int* in_sizes, int n_in, void* d_out, int out_size, void* d_ws, size_t ws_size, hipStream_t stream) {
    static int grid_blocks = 0;
    if (!grid_blocks) {
        int dev = 0, cus = 0, per_cu = 0;
        hipGetDevice(&dev);
        hipDeviceGetAttribute(&cus, hipDeviceAttributeMultiprocessorCount, dev);
        if (hipFuncSetAttribute((const void*)hybrid_fwd, hipFuncAttributeMaxDynamicSharedMemorySize, LDS_BYTES) != hipSuccess) fprintf(stderr, "hipFuncSetAttribute failed\n");
        hipOccupancyMaxActiveBlocksPerMultiprocessor(&per_cu, (const void*)hybrid_fwd, 512, LDS_BYTES);
        if (per_cu < 1) per_cu = 1;
        grid_blocks = cus * per_cu;
        if (ws_size < WS_END) fprintf(stderr, "workspace too small: %zu < %zu\n", ws_size, (size_t)WS_END);
    }
    Params p{};
    for (int i = 0; i < 29; ++i) p.in[i] = (const float*)d_in[i];
    p.out = (float*)d_out; p.ws = (unsigned char*)d_ws;
    void* args[] = {&p};
    hipError_t e = hipLaunchCooperativeKernel((const void*)hybrid_fwd, dim3(grid_blocks), dim3(512), args, LDS_BYTES, stream);
    if (e != hipSuccess) fprintf(stderr, "cooperative launch failed: %s (grid %d)\n", hipGetErrorString(e), grid_blocks);
}
```

```cpp
#include <hip/hip_runtime.h>
#include <hip/hip_cooperative_groups.h>
#include <cstdio>
namespace cg = cooperative_groups;

constexpr int DM = 1024, NB = 16, SEQ = 2048, DEPTH = 4, CTXL = 256;
constexpr int NLAT = NB * SEQ, NCTX = NB * CTXL, MTOK = NLAT + NCTX;
constexpr int NIN = 2080, NINP = 2304;
constexpr int OQ = 0, OKK = 384, OV = 768, OCQ = 1152, OCKV = 1408, OKR = 1536, OLX = 1568, OLG = 1824;
constexpr int FF = 2816, OW = 1280;
constexpr float EPS = 1e-6f;
constexpr float NA_SCALE = 0.125f;
constexpr float LOG2E = 1.4426950408889634f;
constexpr float MLA_SCALE = 0.10206207261596575f * LOG2E;
constexpr float NA_QSCALE = 0.125f * LOG2E;

constexpr size_t WS_MOD = 0;
constexpr size_t WS_HC = WS_MOD + (size_t)4 * 17 * 6144 * 4;
constexpr size_t WS_WIN = WS_HC + (size_t)NCTX * DM * 4;
constexpr size_t WS_WOUT = WS_WIN + (size_t)4 * NINP * DM * 2;
constexpr size_t WS_WGU = WS_WOUT + (size_t)4 * DM * OW * 2;
constexpr size_t WS_WD = WS_WGU + (size_t)4 * 2 * FF * DM * 2;
constexpr size_t WS_AO = WS_WD + (size_t)4 * DM * FF * 2;
constexpr size_t WS_U = WS_AO + (size_t)MTOK * OW * 2;
constexpr size_t WS_MQ = WS_U + (size_t)MTOK * NINP * 2;
constexpr size_t WS_MK = WS_MQ + (size_t)MTOK * 576 * 2;
constexpr size_t WS_MV = WS_MK + (size_t)MTOK * 576 * 2;
constexpr size_t WS_A2 = WS_MV + (size_t)MTOK * 384 * 2;
constexpr size_t WS_WUP = WS_A2 + (size_t)MTOK * 384 * 2;
constexpr size_t WS_ROPE = WS_WUP + (size_t)4 * 1536 * 384 * 2;
constexpr size_t WS_BAR = WS_ROPE + 64 * 8 * 2 * 4 + 64 * 4;
constexpr size_t WS_Q = WS_BAR + 3456 * 4;
constexpr size_t WS_END = WS_Q + 4 * 8 * 64 * 4;
constexpr size_t WS_HID = WS_U;
static_assert((size_t)MTOK * FF * 2 <= WS_MK - WS_U, "Hid alias");
static_assert(WS_END <= (size_t)512 * 1024 * 1024, "workspace");

constexpr int LDS_BYTES = 131072 + 16;

typedef unsigned short bf16_t;
__device__ __forceinline__ float bf2f(bf16_t v) { return __uint_as_float(((unsigned)v) << 16); }
__device__ __forceinline__ float bflo(unsigned w) { return __uint_as_float(w << 16); }
__device__ __forceinline__ float bfhi(unsigned w) { return __uint_as_float(w & 0xffff0000u); }
typedef float g_f32x2 __attribute__((ext_vector_type(2)));
typedef __bf16 g_bf16x2 __attribute__((ext_vector_type(2)));
__device__ __forceinline__ unsigned pk2(float lo, float hi) { const g_f32x2 f = {lo, hi}; return __builtin_bit_cast(unsigned, __builtin_convertvector(f, g_bf16x2)); }
__device__ __forceinline__ bf16_t f2bf(float f) { return (bf16_t)(pk2(f, 0.0f) & 0xffffu); }
template <int K> __device__ __forceinline__ float swz(float v) { return __int_as_float(__builtin_amdgcn_ds_swizzle(__float_as_int(v), (K << 10) | 0x1f)); }
__device__ __forceinline__ float x32_sum(float v) { auto r = __builtin_amdgcn_permlane32_swap(__float_as_uint(v), __float_as_uint(v), false, false); return __uint_as_float(r[0]) + __uint_as_float(r[1]); }
__device__ __forceinline__ float x32_max(float v) { auto r = __builtin_amdgcn_permlane32_swap(__float_as_uint(v), __float_as_uint(v), false, false); return fmaxf(__uint_as_float(r[0]), __uint_as_float(r[1])); }
__device__ __forceinline__ float wave_sum(float v) {
    v += swz<1>(v); v += swz<2>(v); v += swz<4>(v); v += swz<8>(v); v += swz<16>(v);
    return x32_sum(v);
}

struct Params { const float* in[29]; float* out; unsigned char* ws; };

__device__ __forceinline__ unsigned long long karg_q(int i) {
    typedef const __attribute__((address_space(4))) unsigned long long* kp_t;
    kp_t ka = (kp_t)__builtin_amdgcn_kernarg_segment_ptr();
    return *(volatile kp_t)(ka + i);
}
#define GASP __attribute__((address_space(1)))
#define PIN(i) ((const float*)(const GASP float*)karg_q(i))
#define POUT ((float*)(GASP float*)karg_q(29))
#define PWS ((unsigned char*)(GASP unsigned char*)karg_q(30))
__device__ __forceinline__ int obid() { int b = blockIdx.x; asm volatile("" : "+s"(b)); return b; }
__device__ __forceinline__ int otid() { int t = threadIdx.x; asm volatile("" : "+v"(t)); return t; }

namespace pg8 {
#define PG8_LAS __attribute__((address_space(3)))
typedef unsigned short bf16_t;
typedef short bf16x8 __attribute__((ext_vector_type(8)));
typedef float f32x4 __attribute__((ext_vector_type(4)));
typedef unsigned u32x4 __attribute__((ext_vector_type(4)));
typedef unsigned u32x2 __attribute__((ext_vector_type(2)));
constexpr int BM = 256, BK = 64, HALF = 128, HTB = HALF * BK * 2  , STAGE_BYTES = 8 * HTB, NXCD = 8, WGM = 8;

__host__ __device__ __forceinline__ int lds_byte(int r, int c) { const int st = (r >> 4) * 2 + (c >> 5), rr = r & 15, cc = c & 31, ob = rr * 64 + cc * 2; return st * 1024 + (ob ^ (((ob >> 9) & 1) << 5)); }
__host__ __device__ __forceinline__ void stage_rc(int b, int& R, int& C) { const int st = b / 1024, sb = b % 1024, swz = sb ^ (((sb >> 9) & 1) << 5); R = (st >> 1) * 16 + swz / 64; C = (st & 1) * 32 + (swz % 64) / 2; }
__host__ __device__ __forceinline__ int perm32(int rho) { const int n = rho >> 4, i = rho & 15; return 8 * (i >> 2) + 4 * n + (i & 3); }

struct Unit { int pm, pn, kh, k0, kn; };
struct Gemm { const bf16_t* A; const bf16_t* Bt; int M, N, K; };

struct StaticOrder {
    static constexpr bool SPLIT = false;
    int nM, nN, nwg, G, c;
    __host__ __device__ void init(int M, int N, int G_, int c_) { nM = M / BM; nN = N / BM; nwg = nM * nN; G = G_; c = c_; }
    __host__ __device__ bool next(int i, Unit& u) const {
        const long L = (long)i * G + c; if (L >= nwg) return false;
        int wgid = (int)L; { const int q = nwg / NXCD, r = nwg % NXCD, xcd = wgid % NXCD, off = wgid / NXCD; wgid = (xcd < r ? xcd * (q + 1) : r * (q + 1) + (xcd - r) * q) + off; }
        const int nig = WGM * nN, gid = wgid / nig, fm = gid * WGM, gsz = (nM - fm) < WGM ? (nM - fm) : WGM;
        u.pm = fm + ((wgid % nig) % gsz); u.pn = (wgid % nig) / gsz; u.kh = -1; return true;
    }
    __device__ __forceinline__ void a_ready(const Unit&) const {}
    __device__ __forceinline__ void done(const Unit&) const {}
};


struct CtxSplitOrder {
    static constexpr bool SPLIT = true;
    StaticOrder lat; int G, c, nctx;
    __device__ void init(bool has_ctx, int G_, int c_) { lat.init(32768, 1024, G_, c_); G = G_; c = c_; nctx = has_ctx ? 128 : 0; }
    __device__ bool next(int i, Unit& u) const {
        long L = (long)i * G + c; if (L < 512) return lat.next(i, u);
        L -= 512; if (L >= nctx) return false;
        const int t = (int)L >> 1; u.pm = 128 + (t >> 2); u.pn = t & 3; u.kh = (int)L & 1; return true;
    }
    __device__ __forceinline__ void krange(const Unit& u, int nt, int& k0, int& kn) const { if (u.kh >= 0) { kn = nt >> 1; k0 = u.kh * kn; } else { k0 = 0; kn = nt; } }
    __device__ __forceinline__ void a_ready(const Unit&) const {}
    __device__ __forceinline__ void done(const Unit&) const {}
};
struct UpOrder : StaticOrder {
    static constexpr bool SPLIT = true;
    __device__ __forceinline__ void krange(const Unit& u, int nt, int& k0, int& kn) const { if (u.pn < 3) { k0 = 0; kn = 4; } else { k0 = 4; kn = 2; } }
};

typedef float f32x2c __attribute__((ext_vector_type(2)));
typedef __bf16 bf16x2c __attribute__((ext_vector_type(2)));
__device__ __forceinline__ unsigned cvt_pk_bf16(float lo, float hi) { const f32x2c f = {lo, hi}; return __builtin_bit_cast(unsigned, __builtin_convertvector(f, bf16x2c)); }
struct EpiBf16 {
    static constexpr bool PERM = true, AFTER_DRAIN = false;
    bf16_t* O; int ldc;
    __device__ __forceinline__ void operator()(const f32x4 (&acc)[2][2][4][2], const Unit& u, int wr, int wc, int fr, int fq) const {
        const int row0 = u.pm * BM + wr * 64 + fr; const int col0 = u.pn * BM + wc * 32 + 8 * fq;
#pragma unroll
        for (int ai = 0; ai < 2; ++ai)
#pragma unroll
            for (int m = 0; m < 4; ++m) { bf16_t* rowp = O + (size_t)(row0 + ai * HALF + m * 16) * ldc + col0;
#pragma unroll
                for (int bj = 0; bj < 2; ++bj) { const f32x4 v0 = acc[ai][bj][m][0], v1 = acc[ai][bj][m][1];
                    u32x4 w; w.x = cvt_pk_bf16(v0[0], v0[1]); w.y = cvt_pk_bf16(v0[2], v0[3]); w.z = cvt_pk_bf16(v1[0], v1[1]); w.w = cvt_pk_bf16(v1[2], v1[3]);
                    *(u32x4*)(rowp + bj * HALF) = w; } }
    }
};
__device__ __forceinline__ float silu_f(float g) { return g * __builtin_amdgcn_rcpf(1.0f + __expf(-g)); }
struct EpiSwiglu {
    static constexpr bool PERM = true, AFTER_DRAIN = false;
    bf16_t* H; int ldh;
    __device__ __forceinline__ void operator()(const f32x4 (&acc)[2][2][4][2], const Unit& u, int wr, int wc, int fr, int fq) const {
        const int row0 = u.pm * BM + wr * 64 + fr; const int col0 = u.pn * HALF + wc * 32 + 8 * fq;
#pragma unroll
        for (int ai = 0; ai < 2; ++ai)
#pragma unroll
            for (int m = 0; m < 4; ++m) { bf16_t* rowp = H + (size_t)(row0 + ai * HALF + m * 16) * ldh + col0;
                const f32x4 g0 = acc[ai][0][m][0], g1 = acc[ai][0][m][1], u0 = acc[ai][1][m][0], u1 = acc[ai][1][m][1];
                u32x4 w; w.x = cvt_pk_bf16(silu_f(g0[0]) * u0[0], silu_f(g0[1]) * u0[1]); w.y = cvt_pk_bf16(silu_f(g0[2]) * u0[2], silu_f(g0[3]) * u0[3]);
                w.z = cvt_pk_bf16(silu_f(g1[0]) * u1[0], silu_f(g1[1]) * u1[1]); w.w = cvt_pk_bf16(silu_f(g1[2]) * u1[2], silu_f(g1[3]) * u1[3]);
                *(u32x4*)rowp = w; }
    }
};
struct EpiRes {
    static constexpr bool PERM = false, AFTER_DRAIN = false;
    const float* in_lat; float* out_lat; const float* in_ctx; float* out_ctx; const float* gate;
    float* part;
    __device__ __forceinline__ void operator()(const f32x4 (&acc)[2][2][4][2], const Unit& u, int wr, int wc, int fr, int fq) const {
        if (u.kh >= 0) {
            float* pb = part + ((size_t)u.kh * 4096 + (size_t)(u.pm - 128) * BM + wr * 64 + fr) * 1024 + u.pn * BM + wc * 32 + 4 * fq;
#pragma unroll
            for (int ai = 0; ai < 2; ++ai)
#pragma unroll
                for (int m = 0; m < 4; ++m)
#pragma unroll
                    for (int bj = 0; bj < 2; ++bj)
#pragma unroll
                        for (int n = 0; n < 2; ++n) *(f32x4*)(pb + (size_t)(ai * HALF + m * 16) * 1024 + bj * HALF + n * 16) = acc[ai][bj][m][n];
            return;
        }
        const bool isctx = u.pm >= 128;
        const float* inb = isctx ? in_ctx : in_lat; float* outb = isctx ? out_ctx : out_lat;
        const int pml = isctx ? u.pm - 128 : u.pm;
        const float* gp = gate + (size_t)(isctx ? 16 : (u.pm >> 3)) * 6144;
        const int row0 = pml * BM + wr * 64 + fr, col0 = u.pn * BM + wc * 32 + 4 * fq;
        f32x4 gv[2][2];
#pragma unroll
        for (int bj = 0; bj < 2; ++bj)
#pragma unroll
            for (int n = 0; n < 2; ++n) gv[bj][n] = *(const f32x4*)(gp + col0 + bj * HALF + n * 16);
#pragma unroll
        for (int ai = 0; ai < 2; ++ai)
#pragma unroll
            for (int m = 0; m < 4; ++m) { const size_t ro = (size_t)(row0 + ai * HALF + m * 16) * 1024 + col0;
#pragma unroll
                for (int bj = 0; bj < 2; ++bj)
#pragma unroll
                    for (int n = 0; n < 2; ++n) { const f32x4 x = *(const f32x4*)(inb + ro + bj * HALF + n * 16);
                        *(f32x4*)(outb + ro + bj * HALF + n * 16) = x + gv[bj][n] * acc[ai][bj][m][n]; } }
    }
};


struct EpiMla {
    static constexpr bool PERM = false, AFTER_DRAIN = false;
    int l;
    __device__ __forceinline__ void operator()(const f32x4 (&acc)[2][2][4][2], const Unit& u, int wr, int wc, int, int) const {
        const int lane_ = ::otid() & 63, fr = lane_ & 15, fq = lane_ >> 4;
        unsigned char* ws = PWS;
        const bool isq = u.pn < 3; const int head = (isq ? u.pn : u.pn - 3) * 2 + (wc >> 1), kind = wc & 1;
        const bool latent = u.pm < 128, is_v = !isq && kind == 1, is_rope = isq && kind == 1, rot = is_rope && latent;
        const int sbj = is_rope ? 8 : 32;
        const float* gsrc = is_v ? (const float*)(ws + WS_ROPE) + 1024 : (isq ? PIN(16) + l * 96 : PIN(17) + l * 96);
        const float* g = gsrc + (is_rope ? 64 + 16 * (fq & 1) : 8 * fq);
        const float* rope = (const float*)(ws + WS_ROPE);
        bf16_t* obase = (bf16_t*)(ws + (is_v ? WS_MV : (isq ? WS_MQ : WS_MK)));
        const int ostride = is_v ? 384 : 576;
        const int ocol = is_v ? head * 64 + 8 * fq : head * 96 + (is_rope ? 64 + 16 * (fq & 1) : 8 * fq);
        const float inv_cnt = is_rope ? (1.0f / 32.0f) : (1.0f / 64.0f), sc = isq ? MLA_SCALE : 1.0f;
        const bool st_ok = !is_rope || fq < 2;
        const int rowb = u.pm * BM + wr * 64 + fr;
#pragma unroll
        for (int ai = 0; ai < 2; ++ai)
#pragma unroll
            for (int m = 0; m < 4; ++m) {
                const int row = rowb + ai * HALF + m * 16;
                float ss = 0.f;
#pragma unroll
                for (int j = 0; j < 4; ++j) ss += acc[ai][0][m][0][j] * acc[ai][0][m][0][j] + acc[ai][0][m][1][j] * acc[ai][0][m][1][j] + acc[ai][1][m][0][j] * acc[ai][1][m][0][j] + acc[ai][1][m][1][j] * acc[ai][1][m][1][j];
                ss += ::swz<16>(ss); ss = ::x32_sum(ss);
                float rs = __builtin_amdgcn_rsqf(ss * inv_cnt + 1e-6f) * sc; rs = is_v ? 1.0f : rs;
                const int pos = row & 2047, pp = rot ? ((fq & 1) ? (pos & 63) : (pos >> 6)) : 0;
                const float* rt = rope + pp * 16;
                bf16_t* dst = obase + (unsigned)(row * ostride + ocol);
#pragma unroll
                for (int n = 0; n < 2; ++n) {
                    const f32x4 g1 = *(const f32x4*)(g + 4 * n), g2 = *(const f32x4*)(g + sbj + 4 * n);
                    const f32x4 t0 = *(const f32x4*)(rt + 8 * n), t1 = *(const f32x4*)(rt + 8 * n + 4);
                    const f32x4 c = (f32x4){t0[0], t0[2], t1[0], t1[2]}, s = (f32x4){t0[1], t0[3], t1[1], t1[3]};
                    const f32x4 a1 = acc[ai][0][m][n] * rs * g1, a2 = acc[ai][1][m][n] * rs * g2;
                    const f32x4 o1 = a1 * c - a2 * s, o2 = a1 * s + a2 * c;
                    if (st_ok) { u32x2 w; w.x = cvt_pk_bf16(o1[0], o1[1]); w.y = cvt_pk_bf16(o1[2], o1[3]); *(u32x2*)(dst + 4 * n) = w;
                        w.x = cvt_pk_bf16(o2[0], o2[1]); w.y = cvt_pk_bf16(o2[2], o2[3]); *(u32x2*)(dst + sbj + 4 * n) = w; }
                }
                asm volatile("" ::: "memory");
            }
    }
};

template <class Epi, class Sched>
__device__ __forceinline__ void gemm_phase(PG8_LAS unsigned char* lds, const Gemm g, const Sched& S, const Epi& E) {
    const int tid = otid(), wid = __builtin_amdgcn_readfirstlane(tid >> 6), lane = tid & 63, wr = wid >> 2, wc = wid & 3, fr = lane & 15, fq = lane >> 4;
    const int K = g.K, nt = K / BK;
    unsigned voffA[2], voffB[2];
#pragma unroll
    for (int i = 0; i < 2; ++i) { int R, C; stage_rc(tid * 16 + i * 8192, R, C); const int Rb = Epi::PERM ? ((R & ~31) + perm32(R & 31)) : R;
        voffA[i] = (unsigned)(R * K + C) * 2u; voffB[i] = (unsigned)(Rb * K + C) * 2u; }
    const size_t kstep = (size_t)(BK * 2);
    const size_t hstep = (size_t)HALF * K * 2;
    const size_t tstep = 2 * hstep;
    const unsigned ldsw = (unsigned)wid * 1024u;
    const int foff = lds_byte(fr, fq * 8); const int ua = wr * 8192, ub = wc * 4096;
#define PG8_SA(b, h) (((b) * 2 + (h)) * HTB)
#define PG8_SB(b, h) ((4 + (b) * 2 + (h)) * HTB)
#define PG8_STAGE(bufoff, gbase, voff) do { _Pragma("unroll") for (int _i = 0; _i < 2; ++_i) \
        __builtin_amdgcn_global_load_lds((const unsigned*)((const char*)(gbase) + (voff)[_i]), (PG8_LAS unsigned*)(lds + (bufoff) + ldsw + _i * 8192), 16, 0, 0); } while (0)
#define PG8_LDA(dst, b, h) do { int aoff; asm volatile("v_add_u32 %0, %1, %2" : "=v"(aoff) : "s"(ua), "v"(foff)); _Pragma("unroll") for (int m = 0; m < 4; ++m) _Pragma("unroll") for (int k = 0; k < 2; ++k) dst[m][k] = *(const PG8_LAS bf16x8*)(lds + PG8_SA(b, h) + aoff + m * 2048 + k * 1024); } while (0)
#define PG8_LDB(dst, b, h) do { int boff; asm volatile("v_add_u32 %0, %1, %2" : "=v"(boff) : "s"(ub), "v"(foff)); _Pragma("unroll") for (int n = 0; n < 2; ++n) _Pragma("unroll") for (int k = 0; k < 2; ++k) dst[n][k] = *(const PG8_LAS bf16x8*)(lds + PG8_SB(b, h) + boff + n * 2048 + k * 1024); } while (0)
#define PG8_MMA(ai, bj, At, Bt) do { __builtin_amdgcn_s_setprio(1); _Pragma("unroll") for (int m = 0; m < 4; ++m) _Pragma("unroll") for (int n = 0; n < 2; ++n) _Pragma("unroll") for (int k = 0; k < 2; ++k) \
        acc[ai][bj][m][n] = __builtin_amdgcn_mfma_f32_16x16x32_bf16(Bt[n][k], At[m][k], acc[ai][bj][m][n], 0, 0, 0); __builtin_amdgcn_s_setprio(0); } while (0)
#define PG8_WAIT_V(n) asm volatile("s_waitcnt vmcnt(" #n ")" ::: "memory")
#define PG8_WAIT_L(n) asm volatile("s_waitcnt lgkmcnt(" #n ")" ::: "memory")
#define PG8_BAR __builtin_amdgcn_s_barrier()
#define PG8_SCHED __builtin_amdgcn_sched_barrier(0)
    Unit cur, nxt; int ui = 0;
    if (!S.next(0, cur)) return;
    f32x4 acc[2][2][4][2];
#pragma unroll
    for (int a = 0; a < 2; ++a)
#pragma unroll
        for (int b = 0; b < 2; ++b)
#pragma unroll
            for (int m = 0; m < 4; ++m)
#pragma unroll
                for (int n = 0; n < 2; ++n) acc[a][b][m][n] = (f32x4){0.f, 0.f, 0.f, 0.f};
    bf16x8 At[4][2], B0[2][2], B1[2][2];
    int cnt = nt;
    size_t ck = 0;
    if constexpr (Sched::SPLIT) { int k0_, kn_; S.krange(cur, nt, k0_, kn_); cnt = kn_; ck = (size_t)k0_ * kstep; }
    const char* cA = (const char*)g.A + (size_t)cur.pm * tstep + ck; const char* cB = (const char*)g.Bt + (size_t)cur.pn * tstep + ck;
    S.a_ready(cur);
    PG8_STAGE(PG8_SB(0, 0), cB, voffB); PG8_STAGE(PG8_SA(0, 0), cA, voffA); PG8_STAGE(PG8_SB(0, 1), cB + hstep, voffB); PG8_STAGE(PG8_SA(0, 1), cA + hstep, voffA);
    if (wr == 1) PG8_BAR;
    PG8_WAIT_V(4); PG8_BAR;
    PG8_STAGE(PG8_SB(1, 0), cB + kstep, voffB); PG8_STAGE(PG8_SA(1, 0), cA + kstep, voffA); PG8_STAGE(PG8_SB(1, 1), cB + hstep + kstep, voffB);
    PG8_WAIT_V(6); PG8_BAR;
    for (;;) {
        const bool has_next = S.next(ui + 1, nxt);
        int ncnt = nt; size_t nk = 0;
        if constexpr (Sched::SPLIT) { if (has_next) { int k0_, kn_; S.krange(nxt, nt, k0_, kn_); ncnt = kn_; nk = (size_t)k0_ * kstep; } }
        const char* nA = has_next ? (const char*)g.A + (size_t)nxt.pm * tstep + nk : cA; const char* nB = has_next ? (const char*)g.Bt + (size_t)nxt.pn * tstep + nk : cB;
        for (int t = 0; t < cnt; t += 2) {
            const bool last = (t == cnt - 2);
            const char* a1 = cA + (size_t)(t + 1) * kstep;
            const char* a2 = last ? nA : cA + (size_t)(t + 2) * kstep; const char* b2 = last ? nB : cB + (size_t)(t + 2) * kstep;
            const char* a3 = a2 + kstep; const char* b3 = b2 + kstep;
            if (last && has_next) S.a_ready(nxt);
            PG8_LDB(B0, 0, 0); PG8_SCHED; PG8_LDA(At, 0, 0); PG8_STAGE(PG8_SA(1, 1), a1 + hstep, voffA);
            PG8_WAIT_L(8); PG8_BAR; PG8_WAIT_L(0); PG8_MMA(0, 0, At, B0); PG8_BAR; PG8_SCHED;
            PG8_LDB(B1, 0, 1); PG8_STAGE(PG8_SB(0, 0), b2, voffB);
            PG8_BAR; PG8_WAIT_L(0); PG8_MMA(0, 1, At, B1); PG8_BAR;
            PG8_LDA(At, 0, 1); PG8_STAGE(PG8_SA(0, 0), a2, voffA);
            PG8_BAR; PG8_WAIT_L(0); PG8_MMA(1, 0, At, B0); PG8_BAR; PG8_SCHED;
            PG8_STAGE(PG8_SB(0, 1), b2 + hstep, voffB);
            PG8_WAIT_V(6); PG8_BAR; PG8_MMA(1, 1, At, B1); PG8_BAR;
            PG8_LDB(B0, 1, 0); PG8_SCHED; PG8_LDA(At, 1, 0); PG8_STAGE(PG8_SA(0, 1), a2 + hstep, voffA);
            PG8_WAIT_L(8); PG8_BAR; PG8_WAIT_L(0); PG8_MMA(0, 0, At, B0); PG8_BAR; PG8_SCHED;
            PG8_LDB(B1, 1, 1); PG8_STAGE(PG8_SB(1, 0), b3, voffB);
            PG8_BAR; PG8_WAIT_L(0); PG8_MMA(0, 1, At, B1); PG8_BAR;
            PG8_LDA(At, 1, 1); PG8_STAGE(PG8_SA(1, 0), a3, voffA);
            PG8_BAR; PG8_WAIT_L(0); PG8_MMA(1, 0, At, B0); PG8_BAR; PG8_SCHED;
            PG8_STAGE(PG8_SB(1, 1), b3 + hstep, voffB);
            PG8_WAIT_V(6); PG8_BAR; PG8_MMA(1, 1, At, B1); PG8_BAR;
        }
        if constexpr (!Epi::AFTER_DRAIN) { E(acc, cur, wr, wc, fr, fq); S.done(cur); }
        if (!has_next) break;
#pragma unroll
        for (int a = 0; a < 2; ++a)
#pragma unroll
            for (int b = 0; b < 2; ++b)
#pragma unroll
                for (int m = 0; m < 4; ++m)
#pragma unroll
                    for (int n = 0; n < 2; ++n) acc[a][b][m][n] = (f32x4){0.f, 0.f, 0.f, 0.f};
        cur = nxt; cA = nA; cB = nB; cnt = ncnt; ++ui;
    }
    PG8_WAIT_V(0);
    if (wr == 0) PG8_BAR;
    PG8_BAR;
    if constexpr (Epi::AFTER_DRAIN) { E.fused(acc, cur, wr, wc, fr, fq, lds, wid, lane); S.done(cur); }
#undef PG8_SA
#undef PG8_SB
#undef PG8_STAGE
#undef PG8_LDA
#undef PG8_LDB
#undef PG8_MMA
#undef PG8_WAIT_V
#undef PG8_WAIT_L
#undef PG8_BAR
#undef PG8_SCHED
}
}


__device__ __forceinline__ void p0_adaln(const Params& P, float* lf) {
    const int tid = otid(), lane = tid & 63, wave = tid >> 6;
    float* sc = lf;
    float* red = lf + 17 * 1024;
    const float* c = PIN(1); const float* cctx = PIN(3);
    const float* ada_w = PIN(4); const float* ada_b = PIN(5);
    float* mod = (float*)(PWS + WS_MOD);
    for (int i = tid; i < 17 * 1024; i += 512) { const int r = i >> 10, k = i & 1023; const float v = r < 16 ? c[r * 1024 + k] : cctx[k]; sc[i] = v / (1.0f + expf(-v)); }
    __syncthreads();
    for (int item = blockIdx.x; item < 768; item += gridDim.x) {
        const int l = item / 192, j0 = (item % 192) * 32;
        const int col = lane & 31, kh = lane >> 5;
        const float* w = ada_w + (size_t)l * 1024 * 6144 + j0 + col;
        float acc[17];
#pragma unroll
        for (int r = 0; r < 17; ++r) acc[r] = 0.f;
        const int kb = wave * 128 + kh * 64;
        for (int k0 = kb; k0 < kb + 64; k0 += 8) {
            float wv[8];
#pragma unroll
            for (int e = 0; e < 8; ++e) wv[e] = w[(size_t)(k0 + e) * 6144];
#pragma unroll
            for (int e = 0; e < 8; ++e)
#pragma unroll
                for (int r = 0; r < 17; ++r) acc[r] += sc[r * 1024 + k0 + e] * wv[e];
        }
#pragma unroll
        for (int r = 0; r < 17; ++r) red[(wave * 17 + r) * 64 + lane] = acc[r];
        __syncthreads();
        for (int i = tid; i < 17 * 32; i += 512) {
            const int r = i >> 5, jj = i & 31; float s = 0.f;
#pragma unroll
            for (int w8 = 0; w8 < 8; ++w8) s += red[(w8 * 17 + r) * 64 + jj] + red[(w8 * 17 + r) * 64 + 32 + jj];
            mod[(size_t)(l * 17 + r) * 6144 + j0 + jj] = s + ada_b[l * 6144 + j0 + jj];
        }
        __syncthreads();
    }
}

__device__ __forceinline__ float cvt_src(const Params& P, int mat, int l, int n, int k) {
    if (mat == 0) return n < NIN ? PIN(8)[((size_t)l * 1024 + k) * NIN + n] : 0.f;
    if (mat == 1) { const int kk = k < 1024 ? k : k - 256; return PIN(25)[((size_t)l * 1024 + kk) * 1024 + n]; }
    if (mat == 2) { const int t = n >> 8, w = n & 255, col = t * 128 + (w & 127);
        const float* src = (w >> 7) ? PIN(27) : PIN(26); return src[((size_t)l * 1024 + k) * FF + col]; }
    if (mat == 3) return PIN(28)[((size_t)l * FF + k) * 1024 + n];
    const int pn = n >> 8, tc = n & 255, wc = (tc >> 5) & 3, ss = ((tc >> 7) << 5) | (8 * ((tc >> 2) & 3) + 4 * ((tc >> 4) & 1) + (tc & 3));
    const int head = (pn % 3) * 2 + (wc >> 1), kind = wc & 1;
    if (pn < 3) {
        if (k >= 256) return 0.f;
        int col;
        if (kind == 0) col = head * 96 + ss;
        else { const int bj = ss >> 5, s5 = ss & 31; if (s5 >= 16) return 0.f; col = head * 96 + 64 + (s5 < 8 ? s5 + 8 * bj : 16 + (s5 - 8) + 8 * bj); }
        return PIN(13)[((size_t)l * 256 + k) * 576 + col];
    }
    if (k < 256) return 0.f;
    return PIN(15)[((size_t)l * 128 + (k - 256)) * 768 + head * 128 + kind * 64 + ss];
}
__device__ __forceinline__ const float* cvt_ptr(int mat, int l, int n, int k) {
    if (mat == 0) return n < NIN ? PIN(8) + ((size_t)l * 1024 + k) * NIN + n : nullptr;
    if (mat == 1) { const int kk = k < 1024 ? k : k - 256; return PIN(25) + ((size_t)l * 1024 + kk) * 1024 + n; }
    if (mat == 2) { const int t = n >> 8, w = n & 255, col = t * 128 + (w & 127);
        const float* s = (w >> 7) ? PIN(27) : PIN(26); return s + ((size_t)l * 1024 + k) * FF + col; }
    if (mat == 3) return PIN(28) + ((size_t)l * FF + k) * 1024 + n;
    const int pn = n >> 8, tc = n & 255, wc = (tc >> 5) & 3, ss = ((tc >> 7) << 5) | (8 * ((tc >> 2) & 3) + 4 * ((tc >> 4) & 1) + (tc & 3));
    const int head = (pn % 3) * 2 + (wc >> 1), kind = wc & 1;
    if (pn < 3) {
        if (k >= 256) return nullptr;
        int col;
        if (kind == 0) col = head * 96 + ss;
        else { const int bj = ss >> 5, s5 = ss & 31; if (s5 >= 16) return nullptr; col = head * 96 + 64 + (s5 < 8 ? s5 + 8 * bj : 16 + (s5 - 8) + 8 * bj); }
        return PIN(13) + ((size_t)l * 256 + k) * 576 + col;
    }
    if (k < 256) return nullptr;
    return PIN(15) + ((size_t)l * 128 + (k - 256)) * 768 + head * 128 + kind * 64 + ss;
}
__device__ __forceinline__ void p0_convert(const Params& P, float* tile) {
    const int tid = otid();
    if (blockIdx.x == 0) { float* rt = (float*)(PWS + WS_ROPE); const int p = tid >> 3, f = tid & 7;
        const float ang = (float)p * expf(-(float)f * (9.210340371976184f * 0.125f)); rt[tid * 2] = cosf(ang); rt[tid * 2 + 1] = sinf(ang); if (tid < 64) rt[1024 + tid] = 1.0f; }
    constexpr int NT = 4 * 3152;
    const int nl = tid & 63, kq = tid >> 6;
    for (int it = blockIdx.x * 4; it < NT; it += gridDim.x * 4) {
        float4 v[4][2];
#pragma unroll
        for (int j = 0; j < 4; ++j) {
            const int item = it + j < NT ? it + j : NT - 1;
            const int l = item / 3152; int r = item % 3152; int mat, ntk;
            if (r < 576) { mat = 0; ntk = 16; } else if (r < 896) { r -= 576; mat = 1; ntk = 20; } else if (r < 2304) { r -= 896; mat = 2; ntk = 16; }
            else if (r < 3008) { r -= 2304; mat = 3; ntk = 44; } else { r -= 3008; mat = 4; ntk = 6; }
            const int n0 = (r / ntk) * 64, k0 = (r % ntk) * 64;
#pragma unroll
            for (int e = 0; e < 2; ++e) { const float* p_ = cvt_ptr(mat, l, n0 + (tid & 15) * 4, k0 + (tid >> 4) + 32 * e); v[j][e] = p_ ? *(const float4*)p_ : make_float4(0.f, 0.f, 0.f, 0.f); }
        }
#pragma unroll
        for (int j = 0; j < 4; ++j)
#pragma unroll
            for (int e = 0; e < 2; ++e) { float* t_ = tile + j * 4160 + ((tid >> 4) + 32 * e) * 65 + (tid & 15) * 4; t_[0] = v[j][e].x; t_[1] = v[j][e].y; t_[2] = v[j][e].z; t_[3] = v[j][e].w; }
        __syncthreads();
#pragma unroll
        for (int j = 0; j < 4; ++j) {
            if (it + j < NT) {
                const int item = it + j;
                const int l = item / 3152; int r = item % 3152; int ntk, Kd; bf16_t* dst;
                if (r < 576) { ntk = 16; Kd = 1024; dst = (bf16_t*)(PWS + WS_WIN) + (size_t)l * NINP * 1024; }
                else if (r < 896) { r -= 576; ntk = 20; Kd = OW; dst = (bf16_t*)(PWS + WS_WOUT) + (size_t)l * 1024 * OW; }
                else if (r < 2304) { r -= 896; ntk = 16; Kd = 1024; dst = (bf16_t*)(PWS + WS_WGU) + (size_t)l * 2 * FF * 1024; }
                else if (r < 3008) { r -= 2304; ntk = 44; Kd = FF; dst = (bf16_t*)(PWS + WS_WD) + (size_t)l * 1024 * FF; }
                else { r -= 3008; ntk = 6; Kd = 384; dst = (bf16_t*)(PWS + WS_WUP) + (size_t)l * 1536 * 384; }
                const int n0 = (r / ntk) * 64, k0 = (r % ntk) * 64;
                const int kp = tid & 31, nh = tid >> 5;
#pragma unroll
                for (int e = 0; e < 4; ++e) { const int nl2 = nh * 4 + e;
                    *(unsigned*)(dst + (size_t)(n0 + nl2) * Kd + k0 + 2 * kp) = pk2(tile[j * 4160 + (2 * kp) * 65 + nl2], tile[j * 4160 + (2 * kp + 1) * 65 + nl2]); }
            }
        }
        __syncthreads();
    }
}

__device__ __forceinline__ void p_norm(const float* hlat, const float* hctx, const float* g, const float* modl, int sh_off, int sc_off, bf16_t* A, int M,
                                       const float* part, const float* cgate, float* hcout) {
    const int tid = otid(), lane = tid & 63, wave = tid >> 6;
    const int stride = gridDim.x * 8;
    int row = obid() * 8 + wave;
    float4 v[4], nv[4];
#define PN_LOAD(dst, rw) do { const float* s_ = (rw) < NLAT ? hlat + (size_t)(rw) * 1024 : hctx + (size_t)((rw) - NLAT) * 1024; \
        _Pragma("unroll") for (int i = 0; i < 4; ++i) dst[i] = *(const float4*)(s_ + i * 256 + lane * 4); } while (0)
    if (row < M) PN_LOAD(v, row);
    while (row < M) {
        const int nrow = row + stride;
        if (nrow < M) PN_LOAD(nv, nrow);
        const int r = row < NLAT ? (row >> 11) : 16;
        float ss = 0.f;
#pragma unroll
        for (int i = 0; i < 4; ++i) {
            if (part != nullptr && row >= NLAT) {
                const size_t po = (size_t)(row - NLAT) * 1024 + i * 256 + lane * 4;
                const float4 p0 = *(const float4*)(part + po), p1 = *(const float4*)(part + (size_t)4096 * 1024 + po), cg = *(const float4*)(cgate + i * 256 + lane * 4);
                v[i].x += cg.x * (p0.x + p1.x); v[i].y += cg.y * (p0.y + p1.y); v[i].z += cg.z * (p0.z + p1.z); v[i].w += cg.w * (p0.w + p1.w);
                *(float4*)(hcout + po) = v[i];
            }
            ss += v[i].x * v[i].x + v[i].y * v[i].y + v[i].z * v[i].z + v[i].w * v[i].w; }
        ss = wave_sum(ss);
        const float rstd = __builtin_amdgcn_rsqf(ss * (1.0f / 1024.0f) + EPS);
        const float* mr = modl + (size_t)r * 6144;
#pragma unroll
        for (int i = 0; i < 4; ++i) {
            const int k = i * 256 + lane * 4;
            const float4 gg = *(const float4*)(g + k), scv = *(const float4*)(mr + sc_off + k), shv = *(const float4*)(mr + sh_off + k);
            const float o0 = v[i].x * rstd * gg.x * (1.0f + scv.x) + shv.x, o1 = v[i].y * rstd * gg.y * (1.0f + scv.y) + shv.y;
            const float o2 = v[i].z * rstd * gg.z * (1.0f + scv.z) + shv.z, o3 = v[i].w * rstd * gg.w * (1.0f + scv.w) + shv.w;
            uint2 w; w.x = pk2(o0, o1); w.y = pk2(o2, o3);
            *(uint2*)(A + (size_t)row * 1024 + k) = w;
        }
#pragma unroll
        for (int i = 0; i < 4; ++i) v[i] = nv[i];
        row = nrow;
    }
#undef PN_LOAD
}

__device__ __forceinline__ float rope32(float z, int lane, int tokpos) {
    const int l5 = lane & 31, half = l5 >> 4, idx = l5 & 15, f = idx & 7;
    const int pos = half ? (tokpos & 63) : (tokpos >> 6);
    const float inv = expf(-(float)f * (9.210340371976184f * 0.125f));
    const float ang = (float)pos * inv;
    const float cs = cosf(ang), sn = sinf(ang);
    const float p = swz<8>(z);
    return idx < 8 ? z * cs - p * sn : p * sn + z * cs;
}
__device__ __forceinline__ void unpack8(const uint4 r, float (&v)[8]) { v[0] = bflo(r.x); v[1] = bfhi(r.x); v[2] = bflo(r.y); v[3] = bfhi(r.y); v[4] = bflo(r.z); v[5] = bfhi(r.z); v[6] = bflo(r.w); v[7] = bfhi(r.w); }
__device__ __forceinline__ uint4 pack8(const float (&v)[8]) { uint4 w; w.x = pk2(v[0], v[1]); w.y = pk2(v[2], v[3]); w.z = pk2(v[4], v[5]); w.w = pk2(v[6], v[7]); return w; }
__device__ __forceinline__ void p3_prep(const Params& P, int l) {
    const int tid = otid(), lane = tid & 63, wave = tid >> 6;
    bf16_t* U = (bf16_t*)(PWS + WS_U);
    bf16_t* MK = (bf16_t*)(PWS + WS_MK); bf16_t* A2 = (bf16_t*)(PWS + WS_A2);
    const float* rope = (const float*)(PWS + WS_ROPE);
    const int sub = lane & 7;
    float gA[8], gB[8], gC[8];
    { const float* nqg = PIN(9) + l * 64 + sub * 8; const float* nkg = PIN(10) + l * 64 + sub * 8;
#pragma unroll
      for (int j = 0; j < 8; ++j) { gA[j] = lane < 48 ? nqg[j] * NA_QSCALE : nkg[j]; gB[j] = nkg[j]; }
      const float* gc = lane < 32 ? PIN(12) + l * 256 + lane * 8 : (lane < 48 ? PIN(14) + l * 128 + (lane - 32) * 8 : PIN(17) + l * 96 + 64 + ((lane - 48) & 3) * 8);
#pragma unroll
      for (int j = 0; j < 8; ++j) gC[j] = gc[j]; }
    for (int row = obid() * 8 + wave; row < MTOK; row += gridDim.x * 8) {
        bf16_t* u = U + (size_t)row * NINP;
        const bool latent = row < NLAT;
        const uint4 ra = *(const uint4*)(u + lane * 8);
        const uint4 rb = *(const uint4*)(u + 512 + (lane & 31) * 8);
        const uint4 rc = *(const uint4*)(u + OCQ + (lane < 52 ? lane : 51) * 8);
        float v[8];
        unpack8(ra, v);
        { float s = 0.f;
#pragma unroll
          for (int j = 0; j < 8; ++j) s += v[j] * v[j];
          s += swz<1>(s); s += swz<2>(s); s += swz<4>(s);
          const float rs = __builtin_amdgcn_rsqf(s * (1.0f / 64.0f) + EPS);
#pragma unroll
          for (int j = 0; j < 8; ++j) v[j] = v[j] * rs * gA[j];
          *(uint4*)(u + lane * 8) = pack8(v); }
        unpack8(rb, v);
        { float s = 0.f;
#pragma unroll
          for (int j = 0; j < 8; ++j) s += v[j] * v[j];
          s += swz<1>(s); s += swz<2>(s); s += swz<4>(s);
          const float rs = __builtin_amdgcn_rsqf(s * (1.0f / 64.0f) + EPS);
#pragma unroll
          for (int j = 0; j < 8; ++j) v[j] = v[j] * rs * gB[j];
          if (lane < 32) *(uint4*)(u + 512 + lane * 8) = pack8(v); }
        unpack8(rc, v);
        { float s = 0.f;
#pragma unroll
          for (int j = 0; j < 8; ++j) s += v[j] * v[j];
          s += swz<1>(s); const float s2 = s + swz<2>(s); const float s3 = s2 + swz<4>(s2); const float s4 = s3 + swz<8>(s3); const float s5 = s4 + swz<16>(s4);
          const float ms = lane < 32 ? s5 * (1.0f / 256.0f) : (lane < 48 ? s4 * (1.0f / 128.0f) : s2 * (1.0f / 32.0f));
          const float rs = __builtin_amdgcn_rsqf(ms + EPS);
#pragma unroll
          for (int j = 0; j < 8; ++j) v[j] = v[j] * rs * gC[j];
          float pv[8];
#pragma unroll
          for (int j = 0; j < 8; ++j) pv[j] = swz<1>(v[j]);
          if (lane < 48) { *(uint4*)(A2 + (size_t)row * 384 + lane * 8) = pack8(v); }
          else if (lane < 52) {
              const int q4 = lane - 48;
              if (latent) {
                  const int pos = row & 2047, pp = (q4 < 2) ? (pos >> 6) : (pos & 63);
                  const float* rt = rope + pp * 16;
#pragma unroll
                  for (int j = 0; j < 8; ++j) { const float c = rt[2 * j], sn = rt[2 * j + 1];
                      v[j] = (q4 & 1) ? pv[j] * sn + v[j] * c : v[j] * c - pv[j] * sn; }
              }
              const uint4 w = pack8(v);
#pragma unroll
              for (int h = 0; h < 6; ++h) *(uint4*)(MK + (size_t)row * 576 + h * 96 + 64 + q4 * 8) = w;
          } }
    }
}

__device__ __forceinline__ float sigmoid_f(float x) { return 1.0f / (1.0f + expf(-x)); }
__device__ __forceinline__ float gelu_tanh(float x) { return 0.5f * x * (1.0f + tanhf(0.7978845608028654f * (x + 0.044715f * x * x * x))); }
__device__ __forceinline__ void p3_lru(const Params& P, int l, float* lf, int item) {
    const int tid = otid();
    const int b = item >> 3, dir = (item >> 2) & 1, hd = item & 3;
    float* wA = lf; float* wX = lf + 4096; float* xc = lf + 8192; float* av = lf + 12288; float* uv = lf + 16384;
    const float* w_a = PIN(20) + (size_t)((l * 2 + dir) * 4 + hd) * 4096;
    const float* w_x = PIN(22) + (size_t)((l * 2 + dir) * 4 + hd) * 4096;
    __syncthreads();
    for (int i = tid; i < 4096; i += 512) { wA[i] = w_a[i]; wX[i] = w_x[i]; }
    const int j = tid & 63, tq = tid >> 6, c = hd * 64 + j;
    const float ba = PIN(21)[(l * 2 + dir) * 256 + c], bx = PIN(23)[(l * 2 + dir) * 256 + c];
    const float lam = PIN(24)[(l * 2 + dir) * 256 + c];
    const float sp = log1pf(expf(-lam));
    float cw[4];
#pragma unroll
    for (int jj = 0; jj < 4; ++jj) cw[jj] = PIN(18)[(l * 4 + jj) * 256 + c];
    const float cb = PIN(19)[l * 256 + c];
    const bf16_t* U = (const bf16_t*)(PWS + WS_U);
    bf16_t* O = (bf16_t*)(PWS + WS_AO);
    float h = 0.f;
    __syncthreads();
    for (int seg = 0; seg < 2; ++seg) {
        const int base = seg == 0 ? NLAT + b * CTXL : b * SEQ;
        const int len = seg == 0 ? CTXL : SEQ, nch = len >> 6;
        for (int ci = 0; ci < nch; ++ci) {
            const int t0 = (dir ? nch - 1 - ci : ci) * 64;
#pragma unroll
            for (int e = 0; e < 8; ++e) {
                const int t = t0 + tq * 8 + e; float s = cb;
#pragma unroll
                for (int jj = 0; jj < 4; ++jj) { const int tt = t - 1 + jj; if (tt >= 0 && tt < len) s += cw[jj] * bf2f(U[(size_t)(base + tt) * NINP + OLX + c]); }
                xc[(tq * 8 + e) * 64 + j] = s;
            }
            __syncthreads();
            float ga[8], gx[8];
#pragma unroll
            for (int e = 0; e < 8; ++e) { ga[e] = 0.f; gx[e] = 0.f; }
            for (int i = 0; i < 64; ++i) {
                const float a = wA[i * 64 + j], x = wX[i * 64 + j];
#pragma unroll
                for (int e = 0; e < 8; ++e) { const float v = xc[(tq * 8 + e) * 64 + i]; ga[e] += v * a; gx[e] += v * x; }
            }
#pragma unroll
            for (int e = 0; e < 8; ++e) {
                const int tl = tq * 8 + e;
                const float xv = xc[tl * 64 + j];
                const float la = -8.0f * sigmoid_f(ga[e] + ba) * sp;
                av[tl * 64 + j] = expf(la);
                uv[tl * 64 + j] = sqrtf(-expm1f(2.0f * la)) * sigmoid_f(gx[e] + bx) * xv;
            }
            __syncthreads();
            if (tid < 64) {
                if (!dir) { for (int tl = 0; tl < 64; ++tl) { h = av[tl * 64 + j] * h + uv[tl * 64 + j]; uv[tl * 64 + j] = h; } }
                else { for (int tl = 63; tl >= 0; --tl) { h = av[tl * 64 + j] * h + uv[tl * 64 + j]; uv[tl * 64 + j] = h; } }
            }
            __syncthreads();
#pragma unroll
            for (int e = 0; e < 8; ++e) {
                const int tl = tq * 8 + e; const size_t row = (size_t)(base + t0 + tl);
                const float g = bf2f(U[row * NINP + OLG + c]);
                O[row * OW + 768 + dir * 256 + c] = f2bf(gelu_tanh(g) * uv[tl * 64 + j]);
            }
            __syncthreads();
        }
    }
}


typedef short s16x4 __attribute__((ext_vector_type(4)));
typedef short bf16x8_t __attribute__((ext_vector_type(8)));
typedef float f32x4_t __attribute__((ext_vector_type(4)));
typedef unsigned u32x4_t __attribute__((ext_vector_type(4)));
typedef unsigned u32x2_t __attribute__((ext_vector_type(2)));
#define LASP __attribute__((address_space(3)))
template <int DQK>
__device__ __forceinline__ void flash_item(unsigned char* smem, const bf16_t* Q, int qs, const bf16_t* K0, const bf16_t* V0, int n0, const bf16_t* K1, const bf16_t* V1, int n1, int ks, int vs, bf16_t* Oo, int os, float shift) {
    constexpr int KT = 128, NKG = KT / 16, NKP = KT / 32;
    constexpr int KR = DQK * 2 + 16, VR = 144, KCH = DQK / 8, NKK = DQK / 32;
    constexpr int VOFF = 32768;
    constexpr int NKC = KCH / 4;
    constexpr int NVC = 2;
    static_assert(KT * KR <= VOFF, "flash tile geometry");
    const int tid = otid(), lane = tid & 63, wave = tid >> 6, fr = lane & 15, fq = lane >> 4;
    LASP unsigned char* ls = (LASP unsigned char*)smem;
    bf16x8_t qf[2][NKK];
#pragma unroll
    for (int qg = 0; qg < 2; ++qg)
#pragma unroll
        for (int kk = 0; kk < NKK; ++kk) qf[qg][kk] = *(const bf16x8_t*)(Q + (size_t)(wave * 32 + qg * 16 + fr) * qs + kk * 32 + fq * 8);
    f32x4_t o[4][2];
#pragma unroll
    for (int dg = 0; dg < 4; ++dg) { o[dg][0] = (f32x4_t){0.f, 0.f, 0.f, 0.f}; o[dg][1] = (f32x4_t){0.f, 0.f, 0.f, 0.f}; }
    float lsum[2] = {0.f, 0.f};
    const float nsh = -shift;
    const int ntiles = (n0 + n1) / KT;
    u32x4_t kreg[NKC], vreg[NVC];
#define FL_LOAD(key0) do { const bf16_t* Kb = (key0) < n0 ? K0 + (size_t)(key0) * ks : K1 + (size_t)((key0) - n0) * ks; \
        const bf16_t* Vb = (key0) < n0 ? V0 + (size_t)(key0) * vs : V1 + (size_t)((key0) - n0) * vs; \
        _Pragma("unroll") for (int c = 0; c < NKC; ++c) kreg[c] = *(const u32x4_t*)(Kb + (size_t)(tid >> 2) * ks + ((tid & 3) + 4 * c) * 8); \
        _Pragma("unroll") for (int c = 0; c < NVC; ++c) vreg[c] = *(const u32x4_t*)(Vb + (size_t)((tid >> 3) + 64 * c) * vs + (tid & 7) * 8); } while (0)
    FL_LOAD(0);
    for (int t = 0; t < ntiles; ++t) {
        __syncthreads();
#pragma unroll
        for (int c = 0; c < NKC; ++c) *(LASP u32x4_t*)(ls + (tid >> 2) * KR + ((tid & 3) + 4 * c) * 16) = kreg[c];
#pragma unroll
        for (int c = 0; c < NVC; ++c) *(LASP u32x4_t*)(ls + VOFF + ((tid >> 3) + 64 * c) * VR + (tid & 7) * 16) = vreg[c];
        __syncthreads();
        f32x4_t s[NKG][2];
#pragma unroll
        for (int kg = 0; kg < NKG; ++kg) { s[kg][0] = (f32x4_t){nsh, nsh, nsh, nsh}; s[kg][1] = (f32x4_t){nsh, nsh, nsh, nsh}; }
#pragma unroll
        for (int kk = 0; kk < NKK; ++kk) {
#pragma unroll
            for (int kg = 0; kg < NKG; ++kg) {
                const bf16x8_t kf = *(const LASP bf16x8_t*)(ls + (kg * 16 + fr) * KR + (kk * 32 + fq * 8) * 2);
                s[kg][0] = __builtin_amdgcn_mfma_f32_16x16x32_bf16(kf, qf[0][kk], s[kg][0], 0, 0, 0);
                s[kg][1] = __builtin_amdgcn_mfma_f32_16x16x32_bf16(kf, qf[1][kk], s[kg][1], 0, 0, 0);
            }
            asm volatile("" ::: "memory");
        }
        if (t + 1 < ntiles) FL_LOAD((t + 1) * KT);
#pragma unroll
        for (int qg = 0; qg < 2; ++qg) {
            float ps = 0.f;
#pragma unroll
            for (int kg = 0; kg < NKG; ++kg)
#pragma unroll
                for (int j = 0; j < 4; ++j) { const float p = __builtin_amdgcn_exp2f(s[kg][qg][j]); s[kg][qg][j] = p; ps += p; }
            lsum[qg] += ps;
        }
#pragma unroll
        for (int kp = 0; kp < NKP; ++kp) {
            bf16x8_t pb[2];
#pragma unroll
            for (int qg = 0; qg < 2; ++qg) {
                const f32x4_t a = s[2 * kp][qg], b = s[2 * kp + 1][qg];
                u32x4_t pk; pk.x = pg8::cvt_pk_bf16(a[0], a[1]); pk.y = pg8::cvt_pk_bf16(a[2], a[3]); pk.z = pg8::cvt_pk_bf16(b[0], b[1]); pk.w = pg8::cvt_pk_bf16(b[2], b[3]);
                pb[qg] = __builtin_bit_cast(bf16x8_t, pk);
            }
#pragma unroll
            for (int dg = 0; dg < 4; ++dg) {
                LASP unsigned char* va = ls + VOFF + (32 * kp + 4 * fq + (fr >> 2)) * VR + (16 * dg + 4 * (fr & 3)) * 2;
                const s16x4 v0 = __builtin_amdgcn_ds_read_tr16_b64_v4i16((LASP s16x4*)va);
                const s16x4 v1 = __builtin_amdgcn_ds_read_tr16_b64_v4i16((LASP s16x4*)(va + 16 * VR));
                const bf16x8_t vf = __builtin_shufflevector(v0, v1, 0, 1, 2, 3, 4, 5, 6, 7);
                o[dg][0] = __builtin_amdgcn_mfma_f32_16x16x32_bf16(vf, pb[0], o[dg][0], 0, 0, 0);
                o[dg][1] = __builtin_amdgcn_mfma_f32_16x16x32_bf16(vf, pb[1], o[dg][1], 0, 0, 0);
            }
        }
    }
#undef FL_LOAD
#pragma unroll
    for (int qg = 0; qg < 2; ++qg) {
        float l = lsum[qg]; l += swz<16>(l); l = x32_sum(l);
        const float inv = 1.0f / l;
        bf16_t* orow = Oo + (size_t)(wave * 32 + qg * 16 + fr) * os + fq * 4;
#pragma unroll
        for (int dg = 0; dg < 4; ++dg) {
            u32x2_t w; w.x = pg8::cvt_pk_bf16(o[dg][qg][0] * inv, o[dg][qg][1] * inv); w.y = pg8::cvt_pk_bf16(o[dg][qg][2] * inv, o[dg][qg][3] * inv);
            *(u32x2_t*)(orow + dg * 16) = w;
        }
    }
}

__device__ __forceinline__ float softplus_neg(float lam) { const float x = __expf(-lam);
    return x < 0.06f ? x * (1.0f - x * (0.5f - x * ((1.0f / 3.0f) - x * (0.25f - x * 0.2f)))) : __logf(1.0f + x); }
__device__ __forceinline__ float one_minus_exp(float y) {
    const float p = -y * (1.0f + y * (0.5f + y * ((1.0f / 6.0f) + y * ((1.0f / 24.0f) + y * ((1.0f / 120.0f) + y * ((1.0f / 720.0f) + y * (1.0f / 5040.0f)))))));
    return y > -0.25f ? p : 1.0f - __expf(y); }
__device__ __forceinline__ void p3_lru2(int l, unsigned char* smem, int item) {
    constexpr int O_XS = 0, O_XC = 9216, O_A = 25600, O_U = 41984, O_SP = 58368, O_SH = 60416, O_HC = 62464;
    const int tid = otid(), lane = tid & 63, wave = tid >> 6, fr = lane & 15, fq = lane >> 4;
    const int b = item >> 3, dir = (item >> 2) & 1, hd = item & 3;
    LASP unsigned char* ls = (LASP unsigned char*)smem;
    LASP float* xcf = (LASP float*)(ls + O_XC); LASP float* Aa = (LASP float*)(ls + O_A); LASP float* Uu = (LASP float*)(ls + O_U);
    LASP float* sP = (LASP float*)(ls + O_SP); LASP float* sH = (LASP float*)(ls + O_SH); LASP float* hc = (LASP float*)(ls + O_HC);
    const bf16_t* U = (const bf16_t*)(PWS + WS_U);
    bf16_t* O = (bf16_t*)(PWS + WS_AO);
    const int c8 = tid & 7, tr = tid >> 3;
    float cw[4][8], cb[8];
    { const float* cwp = PIN(18) + (size_t)l * 4 * 256 + hd * 64 + c8 * 8; const float* cbp = PIN(19) + l * 256 + hd * 64 + c8 * 8;
#pragma unroll
      for (int jj = 0; jj < 4; ++jj)
#pragma unroll
          for (int e = 0; e < 8; ++e) cw[jj][e] = cwp[jj * 256 + e];
#pragma unroll
      for (int e = 0; e < 8; ++e) cb[e] = cbp[e]; }
    bf16x8_t wf[2];
    { const float* wsrc = (fr < 8 ? PIN(20) : PIN(22)) + (size_t)((l * 2 + dir) * 4 + hd) * 4096 + 8 * wave + (fr & 7);
#pragma unroll
      for (int kk = 0; kk < 2; ++kk) { u32x4_t pk;
          const int ci = 32 * kk + 8 * fq;
          pk.x = pk2(wsrc[(ci + 0) * 64], wsrc[(ci + 1) * 64]); pk.y = pk2(wsrc[(ci + 2) * 64], wsrc[(ci + 3) * 64]);
          pk.z = pk2(wsrc[(ci + 4) * 64], wsrc[(ci + 5) * 64]); pk.w = pk2(wsrc[(ci + 6) * 64], wsrc[(ci + 7) * 64]);
          wf[kk] = __builtin_bit_cast(bf16x8_t, pk); } }
    const int cg = (l * 2 + dir) * 256 + hd * 64 + 8 * wave + (fr & 7);
    const float ba_ = PIN(21)[cg], bx_ = PIN(23)[cg];
    const float sp = softplus_neg(PIN(24)[cg]);
    const int chl = 8 * wave + (fr & 7);
    __syncthreads();
    if (tid < 128) hc[tid] = 0.f;
    int par = 0;
    for (int seg = 0; seg < 2; ++seg) {
        const int base = seg == 0 ? NLAT + b * CTXL : b * SEQ;
        const int len = seg == 0 ? CTXL : SEQ, nch = len >> 6;
        const bf16_t* Ub = U + (size_t)base * NINP + OLX + hd * 64 + c8 * 8;
        u32x4_t nx[4];
#define LRU_LOAD(tq0) do { _Pragma("unroll") for (int jj = 0; jj < 4; ++jj) { const int tt = (tq0) + tr - 1 + jj; \
            nx[jj] = (tt >= 0 && tt < len) ? *(const u32x4_t*)(Ub + (size_t)tt * NINP) : (u32x4_t){0u, 0u, 0u, 0u}; } } while (0)
        LRU_LOAD((dir ? nch - 1 : 0) * 64);
        for (int ci = 0; ci < nch; ++ci) {
            const int t0 = (dir ? nch - 1 - ci : ci) * 64;
            { float xv[8];
#pragma unroll
              for (int e = 0; e < 8; ++e) xv[e] = cb[e];
#pragma unroll
              for (int jj = 0; jj < 4; ++jj) { const u32x4_t w = nx[jj];
                  xv[0] += cw[jj][0] * bflo(w.x); xv[1] += cw[jj][1] * bfhi(w.x); xv[2] += cw[jj][2] * bflo(w.y); xv[3] += cw[jj][3] * bfhi(w.y);
                  xv[4] += cw[jj][4] * bflo(w.z); xv[5] += cw[jj][5] * bfhi(w.z); xv[6] += cw[jj][6] * bflo(w.w); xv[7] += cw[jj][7] * bfhi(w.w); }
              u32x4_t pk; pk.x = pk2(xv[0], xv[1]); pk.y = pk2(xv[2], xv[3]); pk.z = pk2(xv[4], xv[5]); pk.w = pk2(xv[6], xv[7]);
              *(LASP u32x4_t*)(ls + O_XS + tr * 144 + c8 * 16) = pk;
              *(LASP f32x4_t*)(xcf + tr * 64 + c8 * 8) = (f32x4_t){xv[0], xv[1], xv[2], xv[3]};
              *(LASP f32x4_t*)(xcf + tr * 64 + c8 * 8 + 4) = (f32x4_t){xv[4], xv[5], xv[6], xv[7]}; }
            if (ci + 1 < nch) LRU_LOAD((dir ? nch - 2 - ci : ci + 1) * 64);
            float lgv[8];
#pragma unroll
            for (int e = 0; e < 8; ++e) { const int o = wave * 8 + e, tl = dir ? 63 - o : o;
                lgv[e] = bf2f(U[(size_t)(base + t0 + tl) * NINP + OLG + hd * 64 + lane]); }
            __syncthreads();
            { f32x4_t ga[4];
#pragma unroll
              for (int rg = 0; rg < 4; ++rg) ga[rg] = (f32x4_t){0.f, 0.f, 0.f, 0.f};
#pragma unroll
              for (int kk = 0; kk < 2; ++kk)
#pragma unroll
                  for (int rg = 0; rg < 4; ++rg) {
                      const bf16x8_t xa = *(const LASP bf16x8_t*)(ls + O_XS + (rg * 16 + fr) * 144 + (kk * 32 + fq * 8) * 2);
                      ga[rg] = __builtin_amdgcn_mfma_f32_16x16x32_bf16(xa, wf[kk], ga[rg], 0, 0, 0);
                  }
              const bool lo = fr < 8;
#pragma unroll
              for (int rg = 0; rg < 4; ++rg) {
                  const float r0 = swz<8>(lo ? ga[rg][2] : ga[rg][0]), r1 = swz<8>(lo ? ga[rg][3] : ga[rg][1]);
#pragma unroll
                  for (int jj = 0; jj < 2; ++jj) {
                      const float rcv = jj ? r1 : r0;
                      const float gA_ = lo ? ga[rg][jj] : rcv, gX_ = lo ? rcv : ga[rg][2 + jj];
                      const int tl = rg * 16 + fq * 4 + (lo ? jj : 2 + jj);
                      const float sa = __builtin_amdgcn_rcpf(1.0f + __builtin_amdgcn_exp2f(-(gA_ + ba_) * LOG2E));
                      const float sx = __builtin_amdgcn_rcpf(1.0f + __builtin_amdgcn_exp2f(-(gX_ + bx_) * LOG2E));
                      const float la = -8.0f * sa * sp;
                      const float a = __builtin_amdgcn_exp2f(la * LOG2E), mult = __builtin_amdgcn_sqrtf(one_minus_exp(2.0f * la));
                      Aa[tl * 64 + chl] = a; Uu[tl * 64 + chl] = mult * sx * xcf[tl * 64 + chl];
                  }
              } }
            __syncthreads();
            float hl[8], pp[8];
            { float h = 0.f, p = 1.f;
#pragma unroll
              for (int e = 0; e < 8; ++e) { const int o = wave * 8 + e, tl = dir ? 63 - o : o;
                  const float a = Aa[tl * 64 + lane], u = Uu[tl * 64 + lane];
                  h = a * h + u; p *= a; hl[e] = h; pp[e] = p; }
              sP[wave * 64 + lane] = p; sH[wave * 64 + lane] = h; }
            __syncthreads();
            { float cin = hc[par * 64 + lane];
              for (int s2 = 0; s2 < wave; ++s2) cin = sP[s2 * 64 + lane] * cin + sH[s2 * 64 + lane];
#pragma unroll
              for (int e = 0; e < 8; ++e) { const int o = wave * 8 + e, tl = dir ? 63 - o : o;
                  const float h = hl[e] + pp[e] * cin;
                  const size_t row = (size_t)(base + t0 + tl);
                  const float g = lgv[e];
                  const float gl = g * __builtin_amdgcn_rcpf(1.0f + __builtin_amdgcn_exp2f(-2.3022082f * (g + 0.044715f * g * g * g)));
                  O[row * OW + 768 + dir * 256 + hd * 64 + lane] = f2bf(gl * h);
                  if (e == 7 && wave == 7) hc[(par ^ 1) * 64 + lane] = h; } }
            par ^= 1;
        }
#undef LRU_LOAD
    }
    __syncthreads();
}


__device__ __forceinline__ void na_item(unsigned char* smem, const bf16_t* U, const float* rpb_l, bf16_t* O, int b, int rp, int hp, float shift) {
    constexpr int KR = 144, HSZ = 27648, O_VL = 9216, O_KC = 18432, O_VC = 23040, BUF = 2 * HSZ, O_BIAS = 2 * BUF;
    const int tid = otid(), lane = tid & 63, wave = tid >> 6, fr = lane & 15, fq = lane >> 4;
    const int hh = wave >> 2, qg = wave & 3, h = 2 * hp + hh;
    LASP unsigned char* ls = (LASP unsigned char*)smem;
    LASP float* bias = (LASP float*)(ls + O_BIAS);
    const int rA = 2 * rp, rB = rA + 1;
    const int rsA = min(max(rA - 4, 0), 24), rsB = min(max(rB - 4, 0), 24), dB = rsB - rsA, nst = dB + 8;
    const int kcol0 = min(max(16 * qg - 8, 0), 32);
    const int qc = 16 * qg + fr, cs = min(max(qc - 8, 0), 48);
    const size_t qrowA = (size_t)b * SEQ + rA * 64 + qc, qrowB = qrowA + 64;
    bf16x8_t qfA[2], qfB[2];
#pragma unroll
    for (int kk = 0; kk < 2; ++kk) { qfA[kk] = *(const bf16x8_t*)(U + qrowA * NINP + OQ + h * 64 + kk * 32 + fq * 8); qfB[kk] = *(const bf16x8_t*)(U + qrowB * NINP + OQ + h * 64 + kk * 32 + fq * 8); }
    f32x4_t oA[4], oB[4];
#pragma unroll
    for (int dg = 0; dg < 4; ++dg) { oA[dg] = (f32x4_t){0.f, 0.f, 0.f, 0.f}; oB[dg] = (f32x4_t){0.f, 0.f, 0.f, 0.f}; }
    float lA = 0.f, lB = 0.f;
    const float nsh = -shift;
    const int srow = tid >> 3, sch = tid & 7;
    const int crow = (tid & 255) >> 3, cisv = tid >> 8;
    const size_t latbase = ((size_t)b * SEQ + (size_t)rsA * 64 + srow) * NINP + sch * 8;
    const size_t ctxbase = ((size_t)NLAT + b * CTXL + crow) * NINP + (cisv ? OV : OKK) + sch * 8;
    u32x4_t rg[6];
#define NA_LOAD(step) do { _Pragma("unroll") for (int e = 0; e < 2; ++e) { const int hx = 2 * hp + e; \
        rg[3 * e + 0] = *(const u32x4_t*)(U + latbase + (size_t)(step) * 64 * NINP + OKK + hx * 64); \
        rg[3 * e + 1] = *(const u32x4_t*)(U + latbase + (size_t)(step) * 64 * NINP + OV + hx * 64); \
        if ((step) < 8) rg[3 * e + 2] = *(const u32x4_t*)(U + ctxbase + (size_t)(step) * 32 * NINP + hx * 64); } } while (0)
#define NA_STORE(step) do { LASP unsigned char* sb_ = ls + ((step) & 1) * BUF; _Pragma("unroll") for (int e = 0; e < 2; ++e) { \
        *(LASP u32x4_t*)(sb_ + e * HSZ + srow * KR + sch * 16) = rg[3 * e + 0]; \
        *(LASP u32x4_t*)(sb_ + e * HSZ + O_VL + srow * KR + sch * 16) = rg[3 * e + 1]; \
        if ((step) < 8) *(LASP u32x4_t*)(sb_ + e * HSZ + (cisv ? O_VC : O_KC) + crow * KR + sch * 16) = rg[3 * e + 2]; } } while (0)
    NA_LOAD(0);
    __syncthreads();
    for (int i2 = tid; i2 < 2 * 15 * 32; i2 += 512) { const int e = i2 / 480, rr = (i2 % 480) >> 5, x = i2 & 31;
        bias[i2] = x < 31 ? rpb_l[((2 * hp + e) * 15 + rr) * 31 + x] * LOG2E : 0.f; }
    NA_STORE(0);
    NA_LOAD(1);
    __syncthreads();
    for (int i = 0; i < nst; ++i) {
        if (i + 1 < nst) NA_STORE(i + 1);
        if (i + 2 < nst) NA_LOAD(i + 2);
        LASP unsigned char* base = ls + (i & 1) * BUF + hh * HSZ;
        const bool hasctx = i < 8, latA = i < 8, latB = (i >= dB);
        f32x4_t sA[4], sB[4];
#pragma unroll
        for (int g = 0; g < 4; ++g) { sA[g] = (f32x4_t){nsh, nsh, nsh, nsh}; sB[g] = (f32x4_t){nsh, nsh, nsh, nsh}; }
#pragma unroll
        for (int kk = 0; kk < 2; ++kk) {
#pragma unroll
            for (int g = 0; g < 2; ++g) {
                const bf16x8_t kl = *(const LASP bf16x8_t*)(base + (kcol0 + 16 * g + fr) * KR + (kk * 32 + fq * 8) * 2);
                sA[g] = __builtin_amdgcn_mfma_f32_16x16x32_bf16(kl, qfA[kk], sA[g], 0, 0, 0);
                sB[g] = __builtin_amdgcn_mfma_f32_16x16x32_bf16(kl, qfB[kk], sB[g], 0, 0, 0);
                const bf16x8_t kc = *(const LASP bf16x8_t*)(base + O_KC + (16 * g + fr) * KR + (kk * 32 + fq * 8) * 2);
                sA[2 + g] = __builtin_amdgcn_mfma_f32_16x16x32_bf16(kc, qfA[kk], sA[2 + g], 0, 0, 0);
                sB[2 + g] = __builtin_amdgcn_mfma_f32_16x16x32_bf16(kc, qfB[kk], sB[2 + g], 0, 0, 0);
            }
        }
        const int relA = rsA + i - rA + 7, relB = relA - 1;
        const int brA = min(max(relA, 0), 14), brB = min(max(relB, 0), 14);
#pragma unroll
        for (int g = 0; g < 2; ++g)
#pragma unroll
            for (int j = 0; j < 4; ++j) {
                const int kc = kcol0 + 16 * g + 4 * fq + j;
                const bool valid = (kc >= cs) && (kc < cs + 16);
                const int idx = min(max(kc - qc + 15, 0), 30);
                sA[g][j] = (valid && latA) ? sA[g][j] + bias[(hh * 15 + brA) * 32 + idx] : -INFINITY;
                sB[g][j] = (valid && latB) ? sB[g][j] + bias[(hh * 15 + brB) * 32 + idx] : -INFINITY;
            }
        if (!hasctx) {
#pragma unroll
            for (int g = 2; g < 4; ++g) { sA[g] = (f32x4_t){-INFINITY, -INFINITY, -INFINITY, -INFINITY}; sB[g] = sA[g]; }
        }
        { float psA = 0.f, psB = 0.f;
#pragma unroll
          for (int g = 0; g < 4; ++g)
#pragma unroll
              for (int j = 0; j < 4; ++j) { const float pa = __builtin_amdgcn_exp2f(sA[g][j]); sA[g][j] = pa; psA += pa;
                                            const float pb_ = __builtin_amdgcn_exp2f(sB[g][j]); sB[g][j] = pb_; psB += pb_; }
          lA += psA; lB += psB; }
#pragma unroll
        for (int kp = 0; kp < 2; ++kp) {
            u32x4_t pk;
            pk.x = pg8::cvt_pk_bf16(sA[2 * kp][0], sA[2 * kp][1]); pk.y = pg8::cvt_pk_bf16(sA[2 * kp][2], sA[2 * kp][3]); pk.z = pg8::cvt_pk_bf16(sA[2 * kp + 1][0], sA[2 * kp + 1][1]); pk.w = pg8::cvt_pk_bf16(sA[2 * kp + 1][2], sA[2 * kp + 1][3]);
            const bf16x8_t pbA = __builtin_bit_cast(bf16x8_t, pk);
            pk.x = pg8::cvt_pk_bf16(sB[2 * kp][0], sB[2 * kp][1]); pk.y = pg8::cvt_pk_bf16(sB[2 * kp][2], sB[2 * kp][3]); pk.z = pg8::cvt_pk_bf16(sB[2 * kp + 1][0], sB[2 * kp + 1][1]); pk.w = pg8::cvt_pk_bf16(sB[2 * kp + 1][2], sB[2 * kp + 1][3]);
            const bf16x8_t pbB = __builtin_bit_cast(bf16x8_t, pk);
            LASP unsigned char* vb = kp == 0 ? base + O_VL + (kcol0 + 4 * fq + (fr >> 2)) * KR : base + O_VC + (4 * fq + (fr >> 2)) * KR;
#pragma unroll
            for (int dg = 0; dg < 4; ++dg) {
                LASP unsigned char* va = vb + (16 * dg + 4 * (fr & 3)) * 2;
                const s16x4 v0 = __builtin_amdgcn_ds_read_tr16_b64_v4i16((LASP s16x4*)va);
                const s16x4 v1 = __builtin_amdgcn_ds_read_tr16_b64_v4i16((LASP s16x4*)(va + 16 * KR));
                const bf16x8_t vf = __builtin_shufflevector(v0, v1, 0, 1, 2, 3, 4, 5, 6, 7);
                oA[dg] = __builtin_amdgcn_mfma_f32_16x16x32_bf16(vf, pbA, oA[dg], 0, 0, 0);
                oB[dg] = __builtin_amdgcn_mfma_f32_16x16x32_bf16(vf, pbB, oB[dg], 0, 0, 0);
            }
        }
        __syncthreads();
    }
#undef NA_LOAD
#undef NA_STORE
    { float l = lA; l += swz<16>(l); l = x32_sum(l); const float inv = 1.0f / l;
      bf16_t* orow = O + qrowA * OW + h * 64 + fq * 4;
#pragma unroll
      for (int dg = 0; dg < 4; ++dg) { u32x2_t w; w.x = pg8::cvt_pk_bf16(oA[dg][0] * inv, oA[dg][1] * inv); w.y = pg8::cvt_pk_bf16(oA[dg][2] * inv, oA[dg][3] * inv); *(u32x2_t*)(orow + dg * 16) = w; } }
    { float l = lB; l += swz<16>(l); l = x32_sum(l); const float inv = 1.0f / l;
      bf16_t* orow = O + qrowB * OW + h * 64 + fq * 4;
#pragma unroll
      for (int dg = 0; dg < 4; ++dg) { u32x2_t w; w.x = pg8::cvt_pk_bf16(oB[dg][0] * inv, oB[dg][1] * inv); w.y = pg8::cvt_pk_bf16(oB[dg][2] * inv, oB[dg][3] * inv); *(u32x2_t*)(orow + dg * 16) = w; } }
}

template <int DQK, bool BIAS>
__device__ __forceinline__ void attn_keys(const float (&q)[DQK], const bf16_t* K, int kstride, const bf16_t* V, int vstride, int n, const float* bias, float& m, float& l, float (&acc)[64]) {
    for (int j = 0; j < n; ++j) {
        const uint4* kp = (const uint4*)(K + (size_t)j * kstride);
        float s = BIAS ? bias[j] * LOG2E : 0.f;
#pragma unroll
        for (int c = 0; c < DQK / 8; ++c) { const uint4 w = kp[c];
            s += q[8 * c + 0] * bflo(w.x) + q[8 * c + 1] * bfhi(w.x) + q[8 * c + 2] * bflo(w.y) + q[8 * c + 3] * bfhi(w.y)
               + q[8 * c + 4] * bflo(w.z) + q[8 * c + 5] * bfhi(w.z) + q[8 * c + 6] * bflo(w.w) + q[8 * c + 7] * bfhi(w.w); }
        if (s > m) { const float f = exp2f(m - s); l *= f;
#pragma unroll
            for (int d = 0; d < 64; ++d) acc[d] *= f;
            m = s; }
        const float p = exp2f(s - m); l += p;
        const uint4* vp = (const uint4*)(V + (size_t)j * vstride);
#pragma unroll
        for (int c = 0; c < 8; ++c) { const uint4 w = vp[c];
            acc[8 * c + 0] += p * bflo(w.x); acc[8 * c + 1] += p * bfhi(w.x); acc[8 * c + 2] += p * bflo(w.y); acc[8 * c + 3] += p * bfhi(w.y);
            acc[8 * c + 4] += p * bflo(w.z); acc[8 * c + 5] += p * bfhi(w.z); acc[8 * c + 6] += p * bflo(w.w); acc[8 * c + 7] += p * bfhi(w.w); }
    }
}
template <int DQK> __device__ __forceinline__ void load_q(float (&q)[DQK], const bf16_t* src) {
#pragma unroll
    for (int c = 0; c < DQK / 8; ++c) { const uint4 w = ((const uint4*)src)[c];
        q[8 * c + 0] = bflo(w.x); q[8 * c + 1] = bfhi(w.x); q[8 * c + 2] = bflo(w.y); q[8 * c + 3] = bfhi(w.y);
        q[8 * c + 4] = bflo(w.z); q[8 * c + 5] = bfhi(w.z); q[8 * c + 6] = bflo(w.w); q[8 * c + 7] = bfhi(w.w); }
}
__device__ __forceinline__ void store_o(bf16_t* dst, const float (&acc)[64], float l) {
    const float r = 1.0f / l;
#pragma unroll
    for (int c = 0; c < 8; ++c) { uint4 w; w.x = pk2(acc[8 * c] * r, acc[8 * c + 1] * r); w.y = pk2(acc[8 * c + 2] * r, acc[8 * c + 3] * r);
        w.z = pk2(acc[8 * c + 4] * r, acc[8 * c + 5] * r); w.w = pk2(acc[8 * c + 6] * r, acc[8 * c + 7] * r); ((uint4*)dst)[c] = w; }
}
__device__ __forceinline__ void p4_attn(const Params& P, int l, bool last, unsigned char* smem) {
    for (int it = obid(); it < 128; it += gridDim.x) p3_lru2(l, smem, it);
    const unsigned x0 = (unsigned)__builtin_amdgcn_s_getreg((3 << 11) | 20) & 7u;
    float shift_mla, shift_nac, shift_nal;
    { const int ln = otid() & 63;
      float gq = fmaxf(fabsf(PIN(16)[l * 96 + ln]), fabsf(PIN(16)[l * 96 + 64 + (ln & 31)])), gk = fmaxf(fabsf(PIN(17)[l * 96 + ln]), fabsf(PIN(17)[l * 96 + 64 + (ln & 31)]));
      float nq_ = fabsf(PIN(9)[l * 64 + ln]), nk_ = fabsf(PIN(10)[l * 64 + ln]);
      gq = fmaxf(gq, swz<1>(gq)); gq = fmaxf(gq, swz<2>(gq)); gq = fmaxf(gq, swz<4>(gq)); gq = fmaxf(gq, swz<8>(gq)); gq = fmaxf(gq, swz<16>(gq)); gq = x32_max(gq);
      gk = fmaxf(gk, swz<1>(gk)); gk = fmaxf(gk, swz<2>(gk)); gk = fmaxf(gk, swz<4>(gk)); gk = fmaxf(gk, swz<8>(gk)); gk = fmaxf(gk, swz<16>(gk)); gk = x32_max(gk);
      nq_ = fmaxf(nq_, swz<1>(nq_)); nq_ = fmaxf(nq_, swz<2>(nq_)); nq_ = fmaxf(nq_, swz<4>(nq_)); nq_ = fmaxf(nq_, swz<8>(nq_)); nq_ = fmaxf(nq_, swz<16>(nq_)); nq_ = x32_max(nq_);
      nk_ = fmaxf(nk_, swz<1>(nk_)); nk_ = fmaxf(nk_, swz<2>(nk_)); nk_ = fmaxf(nk_, swz<4>(nk_)); nk_ = fmaxf(nk_, swz<8>(nk_)); nk_ = fmaxf(nk_, swz<16>(nk_)); nk_ = x32_max(nk_);
      shift_mla = __int_as_float(__builtin_amdgcn_readfirstlane(__float_as_int(fminf(96.0f * MLA_SCALE * gq * gk * 1.01f + 0.5f, 60.0f))));
      shift_nac = __int_as_float(__builtin_amdgcn_readfirstlane(__float_as_int(fminf(64.0f * NA_QSCALE * nq_ * nk_ * 1.01f + 0.5f, 60.0f))));
      float bm = 0.f;
      for (int i = ln; i < 6 * 15 * 31; i += 64) bm = fmaxf(bm, fabsf(PIN(11)[(size_t)l * 6 * 15 * 31 + i]));
      bm = fmaxf(bm, swz<1>(bm)); bm = fmaxf(bm, swz<2>(bm)); bm = fmaxf(bm, swz<4>(bm)); bm = fmaxf(bm, swz<8>(bm)); bm = fmaxf(bm, swz<16>(bm)); bm = x32_max(bm);
      shift_nal = __int_as_float(__builtin_amdgcn_readfirstlane(__float_as_int(fminf(64.0f * NA_QSCALE * nq_ * nk_ * 1.01f + 0.5f + bm * LOG2E, 60.0f)))); }
    const int nq = last ? 192 : 216;
    for (int pr = 0; pr < 8; ++pr) {
        const int q = (int)((x0 + pr) & 7u);
        for (;;) {
            volatile LASP unsigned* slot = (volatile LASP unsigned*)((LASP unsigned char*)smem + 131072 + 8);
            __syncthreads();
            if (otid() == 0) *slot = __hip_atomic_fetch_add((unsigned*)(PWS + WS_Q) + (size_t)(l * 8 + q) * 64, 1u, __ATOMIC_RELAXED, __HIP_MEMORY_SCOPE_AGENT);
            __syncthreads();
            const int i = __builtin_amdgcn_readfirstlane((int)*slot);
            if (i >= nq) break;
            unsigned char* ws = PWS;
            const bf16_t* U = (const bf16_t*)(ws + WS_U);
            bf16_t* O = (bf16_t*)(ws + WS_AO);
            if (i >= 96 && i < 192) {
                const int j = i - 96, bp = q * 6 + (j >> 4), r = j & 15;
                na_item(smem, U, PIN(11) + (size_t)l * 6 * 15 * 31, O, bp / 3, r, bp % 3, shift_nal);
            } else if (i >= 204) {
                const int bh = q * 12 + (i - 204), b = bh / 6, h = bh % 6;
                const size_t c0 = (size_t)NLAT + b * CTXL;
                flash_item<64>(smem, U + c0 * NINP + OQ + h * 64, NINP, U + c0 * NINP + OKK + h * 64, U + c0 * NINP + OV + h * 64, CTXL, nullptr, nullptr, 0, NINP, NINP, O + c0 * OW + h * 64, OW, shift_nac);
            } else {
                const bf16_t* MQ = (const bf16_t*)(ws + WS_MQ); const bf16_t* MK = (const bf16_t*)(ws + WS_MK); const bf16_t* MV = (const bf16_t*)(ws + WS_MV);
                const bool lat = i < 96;
                const int bh = q * 12 + (lat ? (i >> 3) : (i - 192)), b = bh / 6, h = bh % 6;
                const size_t c0 = (size_t)NLAT + b * CTXL, l0 = (size_t)b * SEQ;
                const size_t q0 = lat ? l0 + (i & 7) * 256 : c0;
                flash_item<96>(smem, MQ + q0 * 576 + h * 96, 576, MK + c0 * 576 + h * 96, MV + c0 * 384 + h * 64, CTXL, MK + l0 * 576 + h * 96, MV + l0 * 384 + h * 64, lat ? SEQ : 0, 576, 384,
                               O + q0 * OW + 384 + h * 64, OW, shift_mla);
            }
        }
    }
}

#define XB_TMO      128
#define XB_XCNT(j)  (256  + 64 * (j))
#define XB_XSUB(j)  (1280 + 64 * (j))
#define XB_XGEN(j)  (2304 + 64 * (j))
#define XB_TOP      3328
#define XB_TOPGEN   3392
#define XCD_BAR_WORDS 3456
#define XB_SPIN_CAP (1u << 18)
#define LAS __attribute__((address_space(3)))

__device__ __forceinline__ unsigned xb_ld(unsigned* p)              { return __hip_atomic_load(p, __ATOMIC_RELAXED, __HIP_MEMORY_SCOPE_AGENT); }
__device__ __forceinline__ unsigned xb_add(unsigned* p, unsigned v) { return __hip_atomic_fetch_add(p, v, __ATOMIC_RELAXED, __HIP_MEMORY_SCOPE_AGENT); }
__device__ __forceinline__ unsigned xb_xcc_id() { return (unsigned)__builtin_amdgcn_s_getreg((3 << 11) | 20) & 0xFu; }
#define XB_SPIN(cond, bar) do { unsigned _sp = 0; while (cond) { __builtin_amdgcn_s_sleep(1); \
    if ((++_sp & 255u) == 0u) { if (xb_ld(&(bar)[XB_TMO])) break; if (_sp > XB_SPIN_CAP) { atomicAdd(&(bar)[XB_TMO], 1u); break; } } } } while (0)

struct XcdBarrier {
    unsigned* bar; unsigned x;
    volatile LAS unsigned* st;
};

__device__ __forceinline__ XcdBarrier xcd_barrier_post(unsigned* bar, volatile LAS unsigned* st) {
    XcdBarrier b; b.bar = bar; b.x = xb_xcc_id(); b.st = st;
    if (threadIdx.x == 0) (void)xb_add(&bar[XB_XCNT(b.x)], 1u);
    return b;
}
__device__ __forceinline__ void xcd_barrier_complete(unsigned* bar, unsigned x, unsigned& nloc, unsigned& nx) {
    const unsigned G = gridDim.x * gridDim.y * gridDim.z;
    unsigned sum, cnt, mine, sp = 0u;
    for (;;) {
        sum = 0u; cnt = 0u; mine = 0u;
#pragma unroll
        for (unsigned j = 0; j < 16; ++j) { const unsigned c = xb_ld(&bar[XB_XCNT(j)]); sum += c; cnt += (c > 0u) ? 1u : 0u; mine = (j == x) ? c : mine; }
        if (sum == G) break;
        __builtin_amdgcn_s_sleep(1);
        if ((++sp & 255u) == 0u) { if (xb_ld(&bar[XB_TMO])) break; if (sp > XB_SPIN_CAP) { atomicAdd(&bar[XB_TMO], 1u); break; } }
    }
    nloc = mine > 0u ? mine : 1u; nx = cnt > 0u ? cnt : 1u;
}

__device__ __forceinline__ void xcd_barrier(const XcdBarrier& b) {
    asm volatile("s_waitcnt vmcnt(0)" ::: "memory");
    __syncthreads();
    if (threadIdx.x == 0) {
        unsigned* bar = b.bar;
        __builtin_amdgcn_s_waitcnt(0);
        unsigned nloc = b.st[0], nx = b.st[1];
        if (nloc == 0u) { xcd_barrier_complete(bar, b.x, nloc, nx); b.st[0] = nloc; b.st[1] = nx; }
        const unsigned old = xb_add(&bar[XB_XSUB(b.x)], 1u);
        const unsigned gen = old / nloc;
        if (old + 1u == (gen + 1u) * nloc) {
            __builtin_amdgcn_fence(__ATOMIC_RELEASE, "agent");
            asm volatile("s_waitcnt vmcnt(0)" ::: "memory");
            const unsigned og = xb_add(&bar[XB_TOP], 1u);
            const unsigned tg = og / nx;
            if (og + 1u == (tg + 1u) * nx) xb_add(&bar[XB_TOPGEN], 1u);
            else XB_SPIN(xb_ld(&bar[XB_TOPGEN]) == tg, bar);
            __builtin_amdgcn_fence(__ATOMIC_ACQUIRE, "agent");
            xb_add(&bar[XB_XGEN(b.x)], 1u);
            asm volatile("s_waitcnt vmcnt(0)" ::: "memory");
        } else {
            XB_SPIN(xb_ld(&bar[XB_XGEN(b.x)]) == gen, bar);
            __builtin_amdgcn_fence(__ATOMIC_ACQUIRE, "agent");
            asm volatile("s_waitcnt vmcnt(0)" ::: "memory");
        }
    }
    __syncthreads();
}


__global__ void __launch_bounds__(512, 2) hybrid_fwd(Params P) {
    extern __shared__ __attribute__((aligned(16))) unsigned char smem[];
    cg::grid_group grid = cg::this_grid();
    float* lf = (float*)smem;
    PG8_LAS unsigned char* lds = (PG8_LAS unsigned char*)smem;
    const int G = gridDim.x, bid = blockIdx.x;
    float* mod = (float*)(PWS + WS_MOD);
    float* hc = (float*)(PWS + WS_HC);
    bf16_t* AO = (bf16_t*)(PWS + WS_AO);
    bf16_t* U = (bf16_t*)(PWS + WS_U);
    bf16_t* HID = (bf16_t*)(PWS + WS_HID);

    unsigned* barw = (unsigned*)(PWS + WS_BAR);
    if (bid == 0) for (int i = otid(); i < XCD_BAR_WORDS + 4 * 8 * 64; i += 512) barw[i] = 0u;
    if (otid() < 4) ((LASP unsigned*)smem)[32768 + otid()] = 0u;
    __syncthreads();
    p0_adaln(P, lf);
    __syncthreads();
    p0_convert(P, lf);
    grid.sync();
    const XcdBarrier xbar = xcd_barrier_post(barw, (volatile LASP unsigned*)((LASP unsigned char*)smem + 131072));
#define GSYNC() xcd_barrier(xbar)

    for (int l = 0; l < DEPTH; ++l) {
        const bool last = (l == DEPTH - 1);
        const float* modl = mod + (size_t)l * 17 * 6144;
        const float* hl_in = l == 0 ? PIN(0) : POUT;
        const float* hc_in = l == 0 ? PIN(2) : hc;
        const int Mf = last ? NLAT : MTOK;

        p_norm(hl_in, hc_in, PIN(6) + l * 1024, modl, 0, 1024, AO, MTOK, l > 0 ? (const float*)(PWS + WS_MK) : nullptr, mod + (size_t)((l > 0 ? l - 1 : 0) * 17 + 16) * 6144 + 5 * 1024, hc);
        GSYNC();
        { pg8::Gemm g{AO, (const bf16_t*)(PWS + WS_WIN) + (size_t)l * NINP * 1024, MTOK, NINP, 1024};
          pg8::StaticOrder S; S.init(MTOK, NINP, G, obid());
          pg8::EpiBf16 E{U, NINP};
          pg8::gemm_phase<pg8::EpiBf16, pg8::StaticOrder>(lds, g, S, E); }
        GSYNC();
        p3_prep(P, l);
        GSYNC();
        { pg8::Gemm g{(const bf16_t*)(PWS + WS_A2), (const bf16_t*)(PWS + WS_WUP) + (size_t)l * 1536 * 384, MTOK, 1536, 384};
          pg8::UpOrder S; S.init(MTOK, 1536, G, obid());
          pg8::EpiMla E{l};
          pg8::gemm_phase<pg8::EpiMla, pg8::UpOrder>(lds, g, S, E); }
        GSYNC();
        p4_attn(P, l, last, smem);
        GSYNC();
        { pg8::Gemm g{AO, (const bf16_t*)(PWS + WS_WOUT) + (size_t)l * 1024 * OW, Mf, 1024, OW};
          pg8::CtxSplitOrder S; S.init(!last, G, obid());
          pg8::EpiRes E{hl_in, POUT, hc_in, hc, modl + 2 * 1024, (float*)(PWS + WS_MK)};
          pg8::gemm_phase<pg8::EpiRes, pg8::CtxSplitOrder>(lds, g, S, E); }
        GSYNC();
        p_norm(POUT, hc_in, PIN(7) + l * 1024, modl, 3 * 1024, 4 * 1024, AO, Mf, last ? nullptr : (const float*)(PWS + WS_MK), modl + 16 * 6144 + 2 * 1024, hc);
        GSYNC();
        { pg8::Gemm g{AO, (const bf16_t*)(PWS + WS_WGU) + (size_t)l * 2 * FF * 1024, Mf, 2 * FF, 1024};
          pg8::StaticOrder S; S.init(Mf, 2 * FF, G, obid());
          pg8::EpiSwiglu E{HID, FF};
          pg8::gemm_phase<pg8::EpiSwiglu, pg8::StaticOrder>(lds, g, S, E); }
        GSYNC();
        { pg8::Gemm g{HID, (const bf16_t*)(PWS + WS_WD) + (size_t)l * 1024 * FF, Mf, 1024, FF};
          pg8::CtxSplitOrder S; S.init(!last, G, obid());
          pg8::EpiRes E{POUT, POUT, hc, hc, modl + 5 * 1024, (float*)(PWS + WS_MK)};
          pg8::gemm_phase<pg8::EpiRes, pg8::CtxSplitOrder>(lds, g, S, E); }
        GSYNC();
    }
}

extern "C" void kernel_launch(void* const* d_in, const int* in_sizes, int n_in, void* d_out, int out_size, void* d_ws, size_t ws_size, hipStream_t stream) {
    static int grid_blocks = 0;
    if (!grid_blocks) {
        int dev = 0, cus = 0, per_cu = 0;
        hipGetDevice(&dev);
        hipDeviceGetAttribute(&cus, hipDeviceAttributeMultiprocessorCount, dev);
        if (hipFuncSetAttribute((const void*)hybrid_fwd, hipFuncAttributeMaxDynamicSharedMemorySize, LDS_BYTES) != hipSuccess) fprintf(stderr, "hipFuncSetAttribute failed\n");
        hipOccupancyMaxActiveBlocksPerMultiprocessor(&per_cu, (const void*)hybrid_fwd, 512, LDS_BYTES);
        if (per_cu < 1) per_cu = 1;
        grid_blocks = cus * per_cu;
        if (ws_size < WS_END) fprintf(stderr, "workspace too small: %zu < %zu\n", ws_size, (size_t)WS_END);
    }
    Params p{};
    for (int i = 0; i < 29; ++i) p.in[i] = (const float*)d_in[i];
    p.out = (float*)d_out; p.ws = (unsigned char*)d_ws;
    void* args[] = {&p};
    hipError_t e = hipLaunchCooperativeKernel((const void*)hybrid_fwd, dim3(grid_blocks), dim3(512), args, LDS_BYTES, stream);
    if (e != hipSuccess) fprintf(stderr, "cooperative launch failed: %s (grid %d)\n", hipGetErrorString(e), grid_blocks);
}
```
